# Optimizing an MI355X kernel written in HIP

```python
import math
import jax, jax.numpy as jnp
from jax import lax
import numpy as np

D_MODEL = 1024
BATCH = 4
SEQ = 4096
DEPTH = 1

CHUNK = 64
Q_BLOCK = 128
N_MEM = 256
MIX_WIDTH = D_MODEL
FOX_WIDTH = MIX_WIDTH // 2
HGRN_WIDTH = MIX_WIDTH - FOX_WIDTH
FOX_HEAD_DIM = 64
FOX_HEADS = FOX_WIDTH // FOX_HEAD_DIM
HGRN_KEY_DIM = 128
HGRN_HEADS = HGRN_WIDTH // HGRN_KEY_DIM
HGRN_VAL_DIM = HGRN_WIDTH // HGRN_HEADS
X_HEADS = 4
X_HEAD_DIM = D_MODEL // X_HEADS
D_FF = 4 * D_MODEL
EPS = 1e-6
SPLITS = (FOX_WIDTH, FOX_WIDTH, FOX_WIDTH, FOX_HEADS, HGRN_WIDTH, HGRN_WIDTH, HGRN_WIDTH, HGRN_WIDTH)
IN_COLS = sum(SPLITS)

kernel_name = "hymba_fox_hgrn2_memory_block"


def rmsnorm(x, g):
    xf = x.astype(jnp.float32)
    y = xf * lax.rsqrt(jnp.mean(xf * xf, axis=-1, keepdims=True) + EPS)
    return (y * g.astype(jnp.float32)).astype(x.dtype)


def fox_attention(q, k, v, log_f):
    b_, h_, s_, d_ = q.shape
    nb = s_ // Q_BLOCK
    scale = 1.0 / math.sqrt(d_)
    F = jnp.cumsum(log_f, axis=-1)
    qb = q.reshape(b_, h_, nb, Q_BLOCK, d_).transpose(2, 0, 1, 3, 4)
    Fb = F.reshape(b_, h_, nb, Q_BLOCK).transpose(2, 0, 1, 3)
    pos = jnp.arange(s_, dtype=jnp.int32).reshape(nb, Q_BLOCK)
    key_pos = jnp.arange(s_, dtype=jnp.int32)

    def block(args):
        qi, Fi, pi = args
        s = jnp.einsum('bhqd,bhkd->bhqk', qi, k).astype(jnp.float32) * scale
        s = s + Fi[..., None] - F[:, :, None, :]
        mask = pi[:, None] >= key_pos[None, :]
        s = jnp.where(mask, s, -jnp.inf)
        p = jax.nn.softmax(s, axis=-1)
        return jnp.einsum('bhqk,bhkd->bhqd', p.astype(v.dtype), v)

    out = lax.map(block, (qb, Fb, pos))
    return out.transpose(1, 2, 0, 3, 4).reshape(b_, h_, s_, d_)


def hgrn2_chunkwise(q, f_logit, i, lb):
    b_, s_, _ = q.shape
    n_c = s_ // CHUNK

    def heads(t, d):
        return t.astype(jnp.float32).reshape(b_, n_c, CHUNK, HGRN_HEADS, d).transpose(1, 0, 3, 2, 4)

    lbh = lb.astype(jnp.float32).reshape(HGRN_HEADS, 1, HGRN_KEY_DIM)
    f = lbh + (1.0 - lbh) * jax.nn.sigmoid(heads(f_logit, HGRN_KEY_DIM))
    kk = 1.0 - f
    g = jnp.log(f)
    qq = jax.nn.silu(heads(q, HGRN_KEY_DIM))
    ii = heads(i, HGRN_VAL_DIM)
    causal = jnp.tril(jnp.ones((CHUNK, CHUNK), dtype=bool))

    def step(state, inp):
        qc, kc, ic, gc = inp
        bcum = jnp.cumsum(gc, axis=2)
        diff = bcum[:, :, :, None, :] - bcum[:, :, None, :, :]
        decay = jnp.exp(jnp.where(causal[:, :, None], diff, -jnp.inf))
        attn = jnp.einsum('bhtd,bhsd,bhtsd->bhts', qc, kc, decay)
        intra = jnp.einsum('bhts,bhsv->bhtv', attn, ic)
        inter = jnp.einsum('bhtd,bhdv->bhtv', qc * jnp.exp(bcum), state)
        b_last = bcum[:, :, -1]
        k_dec = kc * jnp.exp(b_last[:, :, None, :] - bcum)
        new_state = jnp.exp(b_last)[..., None] * state + jnp.einsum('bhsd,bhsv->bhdv', k_dec, ic)
        return new_state, intra + inter

    s0 = jnp.zeros((b_, HGRN_HEADS, HGRN_KEY_DIM, HGRN_VAL_DIM), jnp.float32)
    _, outs = lax.scan(step, s0, (qq, kk, ii, g))
    return outs.transpose(1, 0, 3, 2, 4).reshape(b_, s_, HGRN_HEADS, HGRN_VAL_DIM)


def memory_cross_attention(h, mem_n, w_q, w_kv, w_o):
    b_, s_, _ = h.shape
    m_ = mem_n.shape[1]
    q = (h @ w_q).reshape(b_, s_, X_HEADS, X_HEAD_DIM)
    kv = mem_n @ w_kv
    k, v = jnp.split(kv, 2, axis=-1)
    k = k.reshape(b_, m_, X_HEADS, X_HEAD_DIM)
    v = v.reshape(b_, m_, X_HEADS, X_HEAD_DIM)
    s = jnp.einsum('bshd,bmhd->bhsm', q, k).astype(jnp.float32) / math.sqrt(X_HEAD_DIM)
    p = jax.nn.softmax(s, axis=-1)
    o = jnp.einsum('bhsm,bmhd->bshd', p.astype(v.dtype), v).reshape(b_, s_, D_MODEL)
    return o @ w_o


def setup_inputs(seed: int = 0) -> dict:
    key = jax.random.key(seed)
    ks = jax.random.split(key, 20)
    nrm = lambda k, shape, s: jax.random.normal(k, shape, jnp.float32) * s
    gain = lambda k, shape: 1.0 + 0.02 * jax.random.normal(k, shape, jnp.float32)
    return {
        "x": nrm(ks[0], (BATCH, SEQ, D_MODEL), 1.0),
        "mem": nrm(ks[1], (BATCH, N_MEM, D_MODEL), 1.0),
        "norm_mix_g": gain(ks[2], (DEPTH, D_MODEL)),
        "w_in": nrm(ks[3], (DEPTH, D_MODEL, IN_COLS), D_MODEL ** -0.5),
        "fox_f_bias": 1.0 + 0.1 * jax.random.normal(ks[4], (DEPTH, FOX_HEADS), jnp.float32),
        "hgrn_lb_logits": nrm(ks[5], (DEPTH + 1, HGRN_WIDTH), 0.1),
        "hgrn_norm_g": gain(ks[6], (DEPTH, HGRN_VAL_DIM)),
        "w_out": nrm(ks[7], (DEPTH, MIX_WIDTH, D_MODEL), MIX_WIDTH ** -0.5),
        "norm_x_g": gain(ks[8], (DEPTH, D_MODEL)),
        "norm_mem_g": gain(ks[9], (DEPTH, D_MODEL)),
        "w_xq": nrm(ks[10], (DEPTH, D_MODEL, D_MODEL), D_MODEL ** -0.5),
        "w_xkv": nrm(ks[11], (DEPTH, D_MODEL, 2 * D_MODEL), D_MODEL ** -0.5),
        "w_xo": nrm(ks[12], (DEPTH, D_MODEL, D_MODEL), D_MODEL ** -0.5),
        "norm_ff_g": gain(ks[13], (DEPTH, D_MODEL)),
        "w1": nrm(ks[14], (DEPTH, D_MODEL, D_FF), D_MODEL ** -0.5),
        "w2": nrm(ks[15], (DEPTH, D_FF, D_MODEL), D_FF ** -0.5),
        "final_norm_g": gain(ks[16], (D_MODEL,)),
    }


def reference(x, mem, norm_mix_g, w_in, fox_f_bias, hgrn_lb_logits, hgrn_norm_g, w_out,
              norm_x_g, norm_mem_g, w_xq, w_xkv, w_xo, norm_ff_g, w1, w2, final_norm_g):
    b_, s_, _ = x.shape
    lbs = jnp.cumsum(jax.nn.softmax(hgrn_lb_logits.astype(jnp.float32), axis=0), axis=0)
    split_idx = list(np.cumsum(SPLITS)[:-1])
    h = x
    for l in range(DEPTH):
        hn = rmsnorm(h, norm_mix_g[l])
        proj = hn @ w_in[l]
        fq, fk, fv, ff, gq, gf, gi, gg = jnp.split(proj, split_idx, axis=-1)
        to_heads = lambda t: t.reshape(b_, s_, FOX_HEADS, FOX_HEAD_DIM).transpose(0, 2, 1, 3)
        log_f = jax.nn.log_sigmoid((ff + fox_f_bias[l]).astype(jnp.float32)).transpose(0, 2, 1)
        fox_out = fox_attention(to_heads(fq), to_heads(fk), to_heads(fv), log_f)
        fox_out = fox_out.transpose(0, 2, 1, 3).reshape(b_, s_, FOX_WIDTH)
        rec = hgrn2_chunkwise(gq, gf, gi, lbs[l])
        rec = rmsnorm(rec, hgrn_norm_g[l]) * jax.nn.silu(
            gg.astype(jnp.float32).reshape(b_, s_, HGRN_HEADS, HGRN_VAL_DIM))
        rec = rec.reshape(b_, s_, HGRN_WIDTH).astype(h.dtype)
        h = h + jnp.concatenate([fox_out, rec], axis=-1) @ w_out[l]
        mem_n = rmsnorm(mem, norm_mem_g[l])
        h = h + memory_cross_attention(rmsnorm(h, norm_x_g[l]), mem_n, w_xq[l], w_xkv[l], w_xo[l])
        u = rmsnorm(h, norm_ff_g[l]) @ w1[l]
        h = h + jnp.square(jax.nn.relu(u)) @ w2[l]
    return rmsnorm(h, final_norm_g)
```

```cpp
#include <hip/hip_runtime.h>
#include <hip/hip_bf16.h>
#include <cstdio>
#include <cstdint>
#include <cmath>
namespace pg8 {
#define PG8_LAS __attribute__((address_space(3)))
typedef unsigned short bf16_t;
typedef short bf16x8 __attribute__((ext_vector_type(8)));
typedef float f32x4 __attribute__((ext_vector_type(4)));
typedef unsigned u32x4 __attribute__((ext_vector_type(4)));
constexpr int BM = 256, BK = 64, HALF = 128, HTB = HALF * BK * 2  , STAGE_BYTES = 8 * HTB, NXCD = 8, WGM = 8;

__host__ __device__ __forceinline__ int lds_byte(int r, int c) { const int st = (r >> 4) * 2 + (c >> 5), rr = r & 15, cc = c & 31, ob = rr * 64 + cc * 2; return st * 1024 + (ob ^ (((ob >> 9) & 1) << 5)); }
__host__ __device__ __forceinline__ void stage_rc(int b, int& R, int& C) { const int st = b / 1024, sb = b % 1024, swz = sb ^ (((sb >> 9) & 1) << 5); R = (st >> 1) * 16 + swz / 64; C = (st & 1) * 32 + (swz % 64) / 2; }
__host__ __device__ __forceinline__ int perm32(int rho) { const int n = rho >> 4, i = rho & 15; return 8 * (i >> 2) + 4 * n + (i & 3); }

struct Unit { int pm, pn; };
struct Gemm { const bf16_t* A; const bf16_t* Bt; int K; int ld; };

struct StaticOrder {
    int nM, nN, nwg, G, c, pmb; size_t bstride;
    __host__ __device__ void init(int M, int N, int G_, int c_, int pmb_ = 0, size_t bstride_ = 0) { nM = M / BM; nN = N / BM; nwg = nM * nN; G = G_; c = c_; pmb = pmb_; bstride = bstride_; }
    __host__ __device__ bool next(int i, Unit& u) const {
        if (c < 0) return false;
        const long L = (long)i * G + c; if (L >= nwg) return false;
        int wgid = (int)L; { const int q = nwg / NXCD, r = nwg % NXCD, xcd = wgid % NXCD, off = wgid / NXCD; wgid = (xcd < r ? xcd * (q + 1) : r * (q + 1) + (xcd - r) * q) + off; }
        const int nig = WGM * nN, gid = wgid / nig, fm = gid * WGM, gsz = (nM - fm) < WGM ? (nM - fm) : WGM;
        u.pm = fm + ((wgid % nig) % gsz); u.pn = (wgid % nig) / gsz; return true;
    }
    __device__ __forceinline__ size_t a_off(const Unit& u, size_t tstep) const { return (size_t)u.pm * tstep; }
    __device__ __forceinline__ size_t b_off(const Unit& u, size_t tstep) const { return (size_t)u.pn * tstep + (pmb ? (size_t)(u.pm / pmb) * bstride : (size_t)0); }
    __device__ __forceinline__ void a_ready(const Unit&) const {}
    __device__ __forceinline__ void done(const Unit&) const {}
};
struct SmallOrder {
    int mode, L;
    __device__ __forceinline__ bool next(int i, Unit& u) const { if (i != 0 || L < 0 || L >= 64) return false; u.pm = L >> 2; u.pn = L & 3; return true; }
    __device__ __forceinline__ size_t a_off(const Unit& u, size_t tstep) const { return mode == 0 ? (size_t)(u.pm >> 2) * tstep + (size_t)(u.pm & 3) * 512 : (size_t)(u.pm & 3) * tstep + (size_t)u.pn * 512; }
    __device__ __forceinline__ size_t b_off(const Unit& u, size_t tstep) const { return mode == 0 ? (size_t)u.pn * tstep + (size_t)(u.pm & 3) * 512 : (size_t)(u.pm >> 2) * tstep + (size_t)u.pn * 512; }
    __device__ __forceinline__ void a_ready(const Unit&) const {}
    __device__ __forceinline__ void done(const Unit&) const {}
};

__device__ __forceinline__ unsigned cvt_pk_bf16(float lo, float hi) { unsigned r; asm volatile("v_cvt_pk_bf16_f32 %0, %1, %2" : "=v"(r) : "v"(lo), "v"(hi)); return r; }
__device__ __forceinline__ u32x4 pack8(const f32x4 v0, const f32x4 v1) { u32x4 w; w.x = cvt_pk_bf16(v0[0], v0[1]); w.y = cvt_pk_bf16(v0[2], v0[3]); w.z = cvt_pk_bf16(v1[0], v1[1]); w.w = cvt_pk_bf16(v1[2], v1[3]); return w; }
__device__ __forceinline__ float silu_f(float x) { return x * __builtin_amdgcn_rcpf(1.0f + __expf(-x)); }
__device__ __forceinline__ float row_rstd(const float* ss, int row) {
    const f32x4* p = (const f32x4*)(ss + (size_t)row * 16); const f32x4 a = p[0], b = p[1], c = p[2], d = p[3];
    const float s = ((a[0] + a[1]) + (a[2] + a[3])) + ((b[0] + b[1]) + (b[2] + b[3])) + ((c[0] + c[1]) + (c[2] + c[3])) + ((d[0] + d[1]) + (d[2] + d[3]));
    return 1.0f / sqrtf(s * (1.0f / 1024.0f) + 1e-6f);
}

struct EpiBf16 {
    static constexpr bool PERM = true, AFTER_DRAIN = false;
    bf16_t* O; int ldc; int split_cols; size_t split_stride; float scale;
    __device__ __forceinline__ void operator()(const f32x4 (&acc)[2][2][4][2], const Unit& u, int wr, int wc, int fr, int fq) const {
        const int row0 = u.pm * BM + wr * 64 + fr; int colt = u.pn * BM; bf16_t* base = O;
        if (split_cols) { const int t = colt / split_cols; base += (size_t)t * split_stride; colt -= t * split_cols; }
        const int col0 = colt + wc * 32 + 8 * fq;
#pragma unroll
        for (int ai = 0; ai < 2; ++ai)
#pragma unroll
            for (int m = 0; m < 4; ++m) { bf16_t* rowp = base + (size_t)(row0 + ai * HALF + m * 16) * ldc + col0;
#pragma unroll
                for (int bj = 0; bj < 2; ++bj) *(u32x4*)(rowp + bj * HALF) = pack8(acc[ai][bj][m][0] * scale, acc[ai][bj][m][1] * scale); }
    }
};

struct EpiIn {
    static constexpr bool PERM = true, AFTER_DRAIN = false;
    bf16_t* Ob; size_t ostride; float* G; const float* lbl; float qscale;
    __device__ __forceinline__ void operator()(const f32x4 (&acc)[2][2][4][2], const Unit& u, int wr, int wc, int fr, int fq) const {
        const int grp = u.pn >> 1, row0 = u.pm * BM + wr * 64 + fr, col0 = (u.pn & 1) * BM + wc * 32 + 8 * fq;
        if (grp == 4) {
            float lb[2][8];
#pragma unroll
            for (int bj = 0; bj < 2; ++bj)
#pragma unroll
                for (int e = 0; e < 8; ++e) { const int c = col0 + bj * HALF + e; lb[bj][e] = 1.0f / (1.0f + expf(lbl[512 + c] - lbl[c])); }
#pragma unroll
            for (int ai = 0; ai < 2; ++ai)
#pragma unroll
                for (int m = 0; m < 4; ++m) { float* rowp = G + (size_t)(row0 + ai * HALF + m * 16) * 512 + col0;
#pragma unroll
                    for (int bj = 0; bj < 2; ++bj) { f32x4 o[2];
#pragma unroll
                        for (int n = 0; n < 2; ++n)
#pragma unroll
                            for (int e = 0; e < 4; ++e) { const float x = acc[ai][bj][m][n][e], sg = 1.0f / (1.0f + expf(-x)), l = lb[bj][n * 4 + e]; o[n][e] = logf(l + (1.0f - l) * sg); }
                        *(f32x4*)(rowp + bj * HALF) = o[0]; *(f32x4*)(rowp + bj * HALF + 4) = o[1]; } }
            return;
        }
        bf16_t* base = Ob + (size_t)(grp < 4 ? grp : grp - 1) * ostride; const bool act = (grp == 3 || grp == 6); const float sc = (grp == 0) ? qscale : 1.0f;
#pragma unroll
        for (int ai = 0; ai < 2; ++ai)
#pragma unroll
            for (int m = 0; m < 4; ++m) { bf16_t* rowp = base + (size_t)(row0 + ai * HALF + m * 16) * 512 + col0;
#pragma unroll
                for (int bj = 0; bj < 2; ++bj) { f32x4 v0 = acc[ai][bj][m][0], v1 = acc[ai][bj][m][1];
                    if (act) {
#pragma unroll
                        for (int e = 0; e < 4; ++e) { v0[e] = silu_f(v0[e]); v1[e] = silu_f(v1[e]); } }
                    *(u32x4*)(rowp + bj * HALF) = pack8(v0 * sc, v1 * sc); } }
    }
};

struct EpiRes {
    static constexpr bool PERM = true, AFTER_DRAIN = false;
    const float* base; float* out; bf16_t* xb; float* ss;
    __device__ __forceinline__ void operator()(const f32x4 (&acc)[2][2][4][2], const Unit& u, int wr, int wc, int fr, int fq) const {
        const int row0 = u.pm * BM + wr * 64 + fr, col0 = u.pn * BM + wc * 32 + 8 * fq;
#pragma unroll
        for (int ai = 0; ai < 2; ++ai)
#pragma unroll
            for (int m = 0; m < 4; ++m) { const int row = row0 + ai * HALF + m * 16; const size_t off = (size_t)row * 1024 + col0; float q = 0.f;
#pragma unroll
                for (int bj = 0; bj < 2; ++bj) { const f32x4 b0 = *(const f32x4*)(base + off + bj * HALF), b1 = *(const f32x4*)(base + off + bj * HALF + 4);
                    const f32x4 v0 = acc[ai][bj][m][0] + b0, v1 = acc[ai][bj][m][1] + b1;
                    *(f32x4*)(out + off + bj * HALF) = v0; *(f32x4*)(out + off + bj * HALF + 4) = v1;
                    if (xb) *(u32x4*)(xb + off + bj * HALF) = pack8(v0, v1);
                    q += ((v0[0] * v0[0] + v0[1] * v0[1]) + (v0[2] * v0[2] + v0[3] * v0[3])) + ((v1[0] * v1[0] + v1[1] * v1[1]) + (v1[2] * v1[2] + v1[3] * v1[3])); }
                q += __shfl_xor(q, 16); q += __shfl_xor(q, 32);
                if (fq == 0) ss[(size_t)row * 16 + u.pn * 4 + wc] = q; }
    }
};

struct EpiRelu2 {
    static constexpr bool PERM = true, AFTER_DRAIN = false;
    bf16_t* O; const float* ss;
    __device__ __forceinline__ void operator()(const f32x4 (&acc)[2][2][4][2], const Unit& u, int wr, int wc, int fr, int fq) const {
        const int row0 = u.pm * BM + wr * 64 + fr, col0 = u.pn * BM + wc * 32 + 8 * fq;
#pragma unroll
        for (int ai = 0; ai < 2; ++ai)
#pragma unroll
            for (int m = 0; m < 4; ++m) { const int row = row0 + ai * HALF + m * 16; const float rs = row_rstd(ss, row); bf16_t* rowp = O + (size_t)row * 4096 + col0;
#pragma unroll
                for (int bj = 0; bj < 2; ++bj) { f32x4 v0 = acc[ai][bj][m][0] * rs, v1 = acc[ai][bj][m][1] * rs;
#pragma unroll
                    for (int e = 0; e < 4; ++e) { const float a = fmaxf(v0[e], 0.f), b = fmaxf(v1[e], 0.f); v0[e] = a * a; v1[e] = b * b; }
                    *(u32x4*)(rowp + bj * HALF) = pack8(v0, v1); } }
    }
};

struct EpiSoftmax {
    static constexpr bool PERM = true, AFTER_DRAIN = true;
    bf16_t* O; const float* ss;
    __device__ __forceinline__ void fused(f32x4 (&acc)[2][2][4][2], const Unit& u, int wr, int wc, int fr, int fq, PG8_LAS unsigned char* lds, int wid, int lane) const {
        typedef float f32x2v __attribute__((ext_vector_type(2)));
        PG8_LAS f32x2v* P = (PG8_LAS f32x2v*)lds;
        const int row0 = u.pm * BM + wr * 64 + fr, col0 = u.pn * BM + wc * 32 + 8 * fq;
        float mw[2][4];
#pragma unroll
        for (int ai = 0; ai < 2; ++ai)
#pragma unroll
            for (int m = 0; m < 4; ++m) { const float rs = row_rstd(ss, row0 + ai * HALF + m * 16); float mx = -INFINITY;
#pragma unroll
                for (int bj = 0; bj < 2; ++bj)
#pragma unroll
                    for (int n = 0; n < 2; ++n) { acc[ai][bj][m][n] = acc[ai][bj][m][n] * rs; const f32x4 x = acc[ai][bj][m][n]; mx = fmaxf(mx, fmaxf(fmaxf(x[0], x[1]), fmaxf(x[2], x[3]))); }
                mx = fmaxf(mx, __shfl_xor(mx, 16)); mx = fmaxf(mx, __shfl_xor(mx, 32)); float s = 0.f;
#pragma unroll
                for (int bj = 0; bj < 2; ++bj)
#pragma unroll
                    for (int n = 0; n < 2; ++n) { f32x4 x = acc[ai][bj][m][n];
#pragma unroll
                        for (int e = 0; e < 4; ++e) { x[e] = __builtin_amdgcn_exp2f(x[e] - mx); s += x[e]; }
                        acc[ai][bj][m][n] = x; }
                s += __shfl_xor(s, 16); s += __shfl_xor(s, 32);
                mw[ai][m] = mx;
                if (fq == 0) P[(ai * HALF + wr * 64 + m * 16 + fr) * 4 + wc] = (f32x2v){mx, s}; }
        asm volatile("s_waitcnt lgkmcnt(0)" ::: "memory"); __builtin_amdgcn_s_barrier(); asm volatile("" ::: "memory");
#pragma unroll
        for (int ai = 0; ai < 2; ++ai)
#pragma unroll
            for (int m = 0; m < 4; ++m) { const int r = ai * HALF + wr * 64 + m * 16 + fr;
                const f32x2v a = P[r * 4 + 0], b = P[r * 4 + 1], c = P[r * 4 + 2], d = P[r * 4 + 3];
                const float M = fmaxf(fmaxf(a.x, b.x), fmaxf(c.x, d.x));
                const float tot = (a.y * __builtin_amdgcn_exp2f(a.x - M) + b.y * __builtin_amdgcn_exp2f(b.x - M)) + (c.y * __builtin_amdgcn_exp2f(c.x - M) + d.y * __builtin_amdgcn_exp2f(d.x - M));
                const float f = __builtin_amdgcn_exp2f(mw[ai][m] - M) / tot;
                bf16_t* rowp = O + (size_t)(row0 + ai * HALF + m * 16) * 1024 + col0;
#pragma unroll
                for (int bj = 0; bj < 2; ++bj) *(u32x4*)(rowp + bj * HALF) = pack8(acc[ai][bj][m][0] * f, acc[ai][bj][m][1] * f); }
        asm volatile("s_waitcnt lgkmcnt(0)" ::: "memory"); __builtin_amdgcn_s_barrier(); asm volatile("" ::: "memory");
    }
};

template <class Epi, class Sched, bool ALIGN_EPI = false, bool SP2 = false>
__device__ __forceinline__ void gemm_phase(PG8_LAS unsigned char* lds, const Gemm g, const Sched& S, const Epi& E) {
    const int tid = threadIdx.x, wid = __builtin_amdgcn_readfirstlane(tid >> 6), lane = tid & 63, wr = wid >> 2, wc = wid & 3, fr = lane & 15, fq = lane >> 4;
    const int K = g.K, nt = K / BK, LD = g.ld;
    unsigned voffA[2], voffB[2];
#pragma unroll
    for (int i = 0; i < 2; ++i) { int R, C; stage_rc(tid * 16 + i * 8192, R, C); const int Rb = Epi::PERM ? ((R & ~31) + perm32(R & 31)) : R;
        voffA[i] = (unsigned)(R * LD + C) * 2u; voffB[i] = (unsigned)(Rb * LD + C) * 2u; }
    const size_t kstep = (size_t)(BK * 2);
    const size_t hstep = (size_t)HALF * LD * 2;
    const size_t tstep = 2 * hstep;
    const unsigned ldsw = (unsigned)wid * 1024u;
    const int aoff = lds_byte(wr * 64 + fr, fq * 8), boff = lds_byte(wc * 32 + fr, fq * 8);
#define PG8_SA(b, h) (((b) * 2 + (h)) * HTB)
#define PG8_SB(b, h) ((4 + (b) * 2 + (h)) * HTB)
#define PG8_STAGE(bufoff, gbase, voff) do { _Pragma("unroll") for (int _i = 0; _i < 2; ++_i) \
        __builtin_amdgcn_global_load_lds((const unsigned*)((const char*)(gbase) + (voff)[_i]), (PG8_LAS unsigned*)(lds + (bufoff) + ldsw + _i * 8192), 16, 0, 0); } while (0)
#define PG8_LDA(dst, b, h) do { _Pragma("unroll") for (int m = 0; m < 4; ++m) _Pragma("unroll") for (int k = 0; k < 2; ++k) dst[m][k] = *(const PG8_LAS bf16x8*)(lds + PG8_SA(b, h) + aoff + m * 2048 + k * 1024); } while (0)
#define PG8_LDB(dst, b, h) do { _Pragma("unroll") for (int n = 0; n < 2; ++n) _Pragma("unroll") for (int k = 0; k < 2; ++k) dst[n][k] = *(const PG8_LAS bf16x8*)(lds + PG8_SB(b, h) + boff + n * 2048 + k * 1024); } while (0)
#define PG8_MMA(ai, bj, At, Bt) do { __builtin_amdgcn_s_setprio(1); _Pragma("unroll") for (int m = 0; m < 4; ++m) _Pragma("unroll") for (int n = 0; n < 2; ++n) _Pragma("unroll") for (int k = 0; k < 2; ++k) \
        acc[ai][bj][m][n] = __builtin_amdgcn_mfma_f32_16x16x32_bf16(Bt[n][k], At[m][k], acc[ai][bj][m][n], 0, 0, 0); __builtin_amdgcn_s_setprio(0); } while (0)
#define PG8_WAIT_V(n) asm volatile("s_waitcnt vmcnt(" #n ")" ::: "memory")
#define PG8_WAIT_L(n) asm volatile("s_waitcnt lgkmcnt(" #n ")" ::: "memory")
#define PG8_BAR __builtin_amdgcn_s_barrier()
#define PG8_SCHED __builtin_amdgcn_sched_barrier(0)
    Unit cur, nxt; int ui = 0;
    if (!S.next(0, cur)) return;
    f32x4 acc[2][2][4][2];
#pragma unroll
    for (int a = 0; a < 2; ++a)
#pragma unroll
        for (int b = 0; b < 2; ++b)
#pragma unroll
            for (int m = 0; m < 4; ++m)
#pragma unroll
                for (int n = 0; n < 2; ++n) acc[a][b][m][n] = (f32x4){0.f, 0.f, 0.f, 0.f};
    bf16x8 At[4][2], B0[2][2], B1[2][2];
    const char* cA = (const char*)g.A + S.a_off(cur, tstep); const char* cB = (const char*)g.Bt + S.b_off(cur, tstep);
    S.a_ready(cur);
    if constexpr (SP2) {
        PG8_STAGE(PG8_SB(0, 0), cB, voffB); PG8_STAGE(PG8_SB(0, 1), cB + hstep, voffB); PG8_STAGE(PG8_SA(0, 0), cA, voffA); PG8_STAGE(PG8_SA(0, 1), cA + hstep, voffA);
        if (wr == 1) PG8_BAR;
        PG8_WAIT_V(2); PG8_BAR;
        PG8_STAGE(PG8_SB(1, 0), cB + kstep, voffB); PG8_STAGE(PG8_SA(1, 0), cA + kstep, voffA); PG8_STAGE(PG8_SB(1, 1), cB + hstep + kstep, voffB);
        PG8_WAIT_V(6); PG8_BAR;
    } else {
        PG8_STAGE(PG8_SB(0, 0), cB, voffB); PG8_STAGE(PG8_SA(0, 0), cA, voffA); PG8_STAGE(PG8_SB(0, 1), cB + hstep, voffB); PG8_STAGE(PG8_SA(0, 1), cA + hstep, voffA);
        if (wr == 1) PG8_BAR;
        PG8_WAIT_V(4); PG8_BAR;
        PG8_STAGE(PG8_SB(1, 0), cB + kstep, voffB); PG8_STAGE(PG8_SA(1, 0), cA + kstep, voffA); PG8_STAGE(PG8_SB(1, 1), cB + hstep + kstep, voffB);
        PG8_WAIT_V(6); PG8_BAR;
    }
    for (;;) {
        const bool has_next = S.next(ui + 1, nxt);
        const char* nA = has_next ? (const char*)g.A + S.a_off(nxt, tstep) : cA; const char* nB = has_next ? (const char*)g.Bt + S.b_off(nxt, tstep) : cB;
        for (int t = 0; t < nt; t += 2) {
            const bool last = (t == nt - 2);
            const char* a1 = cA + (size_t)(t + 1) * kstep;
            const char* a2 = last ? nA : cA + (size_t)(t + 2) * kstep; const char* b2 = last ? nB : cB + (size_t)(t + 2) * kstep;
            const char* a3 = a2 + kstep; const char* b3 = b2 + kstep;
            if (last && has_next) S.a_ready(nxt);
            if constexpr (SP2) {
            PG8_LDB(B0, 0, 0); PG8_LDB(B1, 0, 1); PG8_SCHED; PG8_LDA(At, 0, 0); PG8_STAGE(PG8_SA(1, 1), a1 + hstep, voffA);
            PG8_WAIT_V(8); PG8_WAIT_L(0); PG8_BAR; PG8_MMA(0, 0, At, B0); PG8_MMA(0, 1, At, B1); PG8_BAR; PG8_SCHED;
            PG8_LDA(At, 0, 1); PG8_STAGE(PG8_SB(0, 0), b2, voffB); PG8_STAGE(PG8_SB(0, 1), b2 + hstep, voffB); PG8_STAGE(PG8_SA(0, 0), a2, voffA);
            PG8_WAIT_V(8); PG8_WAIT_L(0); PG8_BAR; PG8_MMA(1, 0, At, B0); PG8_MMA(1, 1, At, B1); PG8_BAR; PG8_SCHED;
            PG8_LDB(B0, 1, 0); PG8_LDB(B1, 1, 1); PG8_SCHED; PG8_LDA(At, 1, 0); PG8_STAGE(PG8_SA(0, 1), a2 + hstep, voffA);
            PG8_WAIT_V(8); PG8_WAIT_L(0); PG8_BAR; PG8_MMA(0, 0, At, B0); PG8_MMA(0, 1, At, B1); PG8_BAR; PG8_SCHED;
            PG8_LDA(At, 1, 1); PG8_STAGE(PG8_SB(1, 0), b3, voffB); PG8_STAGE(PG8_SB(1, 1), b3 + hstep, voffB); PG8_STAGE(PG8_SA(1, 0), a3, voffA);
            PG8_WAIT_V(8); PG8_WAIT_L(0); PG8_BAR; PG8_MMA(1, 0, At, B0); PG8_MMA(1, 1, At, B1); PG8_BAR; PG8_SCHED;
            } else {
            PG8_LDB(B0, 0, 0); PG8_SCHED; PG8_LDA(At, 0, 0); PG8_STAGE(PG8_SA(1, 1), a1 + hstep, voffA);
            PG8_WAIT_L(8); PG8_BAR; PG8_WAIT_L(0); PG8_MMA(0, 0, At, B0); PG8_BAR; PG8_SCHED;
            PG8_LDB(B1, 0, 1); PG8_STAGE(PG8_SB(0, 0), b2, voffB);
            PG8_BAR; PG8_WAIT_L(0); PG8_MMA(0, 1, At, B1); PG8_BAR;
            PG8_LDA(At, 0, 1); PG8_STAGE(PG8_SA(0, 0), a2, voffA);
            PG8_BAR; PG8_WAIT_L(0); PG8_MMA(1, 0, At, B0); PG8_BAR; PG8_SCHED;
            PG8_STAGE(PG8_SB(0, 1), b2 + hstep, voffB);
            PG8_WAIT_V(6); PG8_BAR; PG8_MMA(1, 1, At, B1); PG8_BAR;
            PG8_LDB(B0, 1, 0); PG8_SCHED; PG8_LDA(At, 1, 0); PG8_STAGE(PG8_SA(0, 1), a2 + hstep, voffA);
            PG8_WAIT_L(8); PG8_BAR; PG8_WAIT_L(0); PG8_MMA(0, 0, At, B0); PG8_BAR; PG8_SCHED;
            PG8_LDB(B1, 1, 1); PG8_STAGE(PG8_SB(1, 0), b3, voffB);
            PG8_BAR; PG8_WAIT_L(0); PG8_MMA(0, 1, At, B1); PG8_BAR;
            PG8_LDA(At, 1, 1); PG8_STAGE(PG8_SA(1, 0), a3, voffA);
            PG8_BAR; PG8_WAIT_L(0); PG8_MMA(1, 0, At, B0); PG8_BAR; PG8_SCHED;
            PG8_STAGE(PG8_SB(1, 1), b3 + hstep, voffB);
            PG8_WAIT_V(6); PG8_BAR; PG8_MMA(1, 1, At, B1); PG8_BAR;
            }
        }
        if constexpr (ALIGN_EPI) { if (wr == 0) PG8_BAR; }
        if constexpr (!Epi::AFTER_DRAIN) { E(acc, cur, wr, wc, fr, fq); S.done(cur); }
        if (!has_next) break;
#pragma unroll
        for (int a = 0; a < 2; ++a)
#pragma unroll
            for (int b = 0; b < 2; ++b)
#pragma unroll
                for (int m = 0; m < 4; ++m)
#pragma unroll
                    for (int n = 0; n < 2; ++n) acc[a][b][m][n] = (f32x4){0.f, 0.f, 0.f, 0.f};
        cur = nxt; cA = nA; cB = nB; ++ui;
        if constexpr (ALIGN_EPI) { if (wr == 1) PG8_BAR; }
    }
    PG8_WAIT_V(0);
    if constexpr (!ALIGN_EPI) { if (wr == 0) PG8_BAR; }
    PG8_BAR;
    if constexpr (Epi::AFTER_DRAIN) { E.fused(acc, cur, wr, wc, fr, fq, lds, wid, lane); S.done(cur); }
#undef PG8_SA
#undef PG8_SB
#undef PG8_STAGE
#undef PG8_LDA
#undef PG8_LDB
#undef PG8_MMA
#undef PG8_WAIT_V
#undef PG8_WAIT_L
#undef PG8_BAR
#undef PG8_SCHED
}
}

#ifndef PG8_SP2
#define PG8_SP2 true
#endif
#ifndef PG8_ALIGN
#define PG8_ALIGN true
#endif
namespace attn_body {
using bf16=__hip_bfloat16;
using bf16x8=__attribute__((ext_vector_type(8)))short;
using s16x4=__attribute__((ext_vector_type(4)))short;
using f32x16=__attribute__((ext_vector_type(16)))float;
using u32x4=__attribute__((ext_vector_type(4)))unsigned;
using f32x4v=__attribute__((ext_vector_type(4)))float;
constexpr int BATCH=4,NHEAD=8,SEQ=4096,D=64,DM=NHEAD*D,DMO=1024;
constexpr int NW=8,QBLK=32,QB=QBLK*NW,KVBLK=64,NQB=SEQ/QB;
constexpr int ATTN_PITCH=DM, ATTN_UNIT_ROWS=QB;
__device__ __forceinline__ int crow(int r,int hi){return (r&3)+8*(r>>2)+4*hi;}
#define SBAR() __builtin_amdgcn_sched_barrier(0)
__device__ __forceinline__ void cmask(f32x16&p0,f32x16&p1,int jb,int qrel,int hi){
  const float NEG=-INFINITY; int kb=64*jb+4*hi;
  #pragma unroll
  for(int r=0;r<16;++r){int kv=kb+(r&3)+8*(r>>2); if(kv>qrel)p0[r]=NEG; if(kv+32>qrel)p1[r]=NEG;}
}

constexpr int NSLOT=3, SLOTB=8192;
constexpr int LDS_K=0, LDS_V=NSLOT*SLOTB, LDS_WS=2*NSLOT*SLOTB, LDS_OST=LDS_WS+NW*64*4, LDS_F=LDS_OST+NW*4096, LDS_BYTES=LDS_F+SEQ*4;
constexpr float C2=0.125f*1.4426950408889634f;
__device__ __forceinline__ void glds16(const void*gsrc,unsigned lds_dst){unsigned keep;
  asm volatile("s_mov_b32 %0, m0\n\ts_mov_b32 m0, %2\n\ts_nop 0\n\tglobal_load_lds_dwordx4 %1, off\n\ts_mov_b32 m0, %0":"=&s"(keep):"v"(gsrc),"s"(lds_dst):"memory");}
__device__ __forceinline__ float max3f(float a,float b,float c){float r;asm("v_max3_f32 %0, %1, %2, %3":"=v"(r):"v"(a),"v"(b),"v"(c));return r;}
__device__ __forceinline__ float max2f(float a,float b){float r;asm("v_max_f32_e32 %0, %1, %2":"=v"(r):"v"(a),"v"(b));return r;}
__device__ __forceinline__ float fadd_s(float a,float b){float r;asm("v_add_f32_e32 %0, %1, %2":"=v"(r):"v"(a),"v"(b));return r;}
__device__ __forceinline__ float fsub_s(float a,float b){float r;asm("v_sub_f32_e32 %0, %1, %2":"=v"(r):"v"(a),"v"(b));return r;}
typedef float f32x2_t __attribute__((ext_vector_type(2))); typedef __bf16 bf16x2_t __attribute__((ext_vector_type(2)));
__device__ __forceinline__ unsigned cvtpk_s(float lo,float hi){f32x2_t v={lo,hi};bf16x2_t b=__builtin_convertvector(v,bf16x2_t);return __builtin_bit_cast(unsigned,b);}
#define WAIT_BAR(N) asm volatile("s_waitcnt vmcnt(" #N ") lgkmcnt(0)\n\ts_barrier":::"memory")

__device__ __forceinline__ void qkt(f32x16&p0,f32x16&p1,const char*Kslot,const bf16x8*qr,int r32,int hi){
  const char*kb=Kslot+hi*1024+r32*16;
  #pragma unroll
  for(int d0=0;d0<4;++d0){
    const bf16x8 b0=*reinterpret_cast<const bf16x8*>(kb+d0*2048);
    const bf16x8 b1=*reinterpret_cast<const bf16x8*>(kb+d0*2048+512);
    {p0=__builtin_amdgcn_mfma_f32_32x32x16_bf16(b0,qr[d0],p0,0,0,0);p1=__builtin_amdgcn_mfma_f32_32x32x16_bf16(b1,qr[d0],p1,0,0,0);}}
}
typedef __attribute__((address_space(3))) const char* lds_cptr;
typedef short v4i16_t __attribute__((ext_vector_type(4)));
__device__ __forceinline__ void kload8(bf16x8*kf,lds_cptr kp){
  kf[0]=*(const __attribute__((address_space(3))) bf16x8*)(kp);      kf[1]=*(const __attribute__((address_space(3))) bf16x8*)(kp+512);
  kf[2]=*(const __attribute__((address_space(3))) bf16x8*)(kp+2048); kf[3]=*(const __attribute__((address_space(3))) bf16x8*)(kp+2560);
  kf[4]=*(const __attribute__((address_space(3))) bf16x8*)(kp+4096); kf[5]=*(const __attribute__((address_space(3))) bf16x8*)(kp+4608);
  kf[6]=*(const __attribute__((address_space(3))) bf16x8*)(kp+6144); kf[7]=*(const __attribute__((address_space(3))) bf16x8*)(kp+6656);
}
__device__ __forceinline__ void kload2(bf16x8*kf,lds_cptr kp,int j){ kf[2*j]=*(const __attribute__((address_space(3))) bf16x8*)(kp+j*2048); kf[2*j+1]=*(const __attribute__((address_space(3))) bf16x8*)(kp+j*2048+512); }
__device__ __forceinline__ s16x4 vtr(lds_cptr p){ return __builtin_bit_cast(s16x4,__builtin_amdgcn_ds_read_tr16_b64_v4i16((__attribute__((address_space(3))) v4i16_t*)p)); }
__device__ __forceinline__ float rowmax(const f32x16&p0,const f32x16&p1){
  float a=max3f(p0[0],p0[1],p1[0]),b=max3f(p0[2],p0[3],p1[1]);a=max3f(a,p1[2],p1[3]);
  #pragma unroll
  for(int r=4;r<16;r+=4){a=max3f(a,p0[r],p0[r+1]);b=max3f(b,p0[r+2],p0[r+3]);a=max3f(a,p1[r],p1[r+1]);b=max3f(b,p1[r+2],p1[r+3]);}
  const float m=max2f(a,b);
  auto rr=__builtin_amdgcn_permlane32_swap(__float_as_uint(m),__float_as_uint(m),false,false);
  return max2f(__uint_as_float(rr[0]),__uint_as_float(rr[1]));
}
__device__ __forceinline__ void pv(f32x16*o,int vb,bf16x8 pa0,bf16x8 pa1,bf16x8 pa2,bf16x8 pa3){
  #pragma unroll
  for(int d0=0;d0<2;++d0){s16x4 lo[4],hi[4];
    #pragma unroll
    for(int ks=0;ks<4;++ks){
      asm volatile("ds_read_b64_tr_b16 %0,%1 offset:%c2":"=&v"(lo[ks]):"v"(vb),"i"(d0*4096+ks*1024):"memory");
      asm volatile("ds_read_b64_tr_b16 %0,%1 offset:%c2":"=&v"(hi[ks]):"v"(vb),"i"(d0*4096+ks*1024+512):"memory");}
    asm volatile("s_waitcnt lgkmcnt(0)":::"memory");SBAR();
    #define PK(k) (bf16x8){lo[k][0],lo[k][1],lo[k][2],lo[k][3],hi[k][0],hi[k][1],hi[k][2],hi[k][3]}
    o[d0]=__builtin_amdgcn_mfma_f32_32x32x16_bf16(pa0,PK(0),o[d0],0,0,0);
    o[d0]=__builtin_amdgcn_mfma_f32_32x32x16_bf16(pa1,PK(1),o[d0],0,0,0);
    o[d0]=__builtin_amdgcn_mfma_f32_32x32x16_bf16(pa2,PK(2),o[d0],0,0,0);
    o[d0]=__builtin_amdgcn_mfma_f32_32x32x16_bf16(pa3,PK(3),o[d0],0,0,0);
    #undef PK
  }
}

#ifndef ATTN_STORE16
#define ATTN_STORE16(p,v) (*(u32x4*)(p)=(v))
#endif
template<int THRL> __device__ __forceinline__ void attn_unit(int b,int h,int qb,const bf16*Q,const bf16*__restrict__ K,const bf16*__restrict__ V,bf16*O,const float*__restrict__ Fp,char*shm){
  const int tid=threadIdx.x,lane=tid&63,r32=lane&31,hi=lane>>5; const int wid=__builtin_amdgcn_readfirstlane(tid>>6);
  const long rowbase=(long)b*SEQ; const int q0=qb*QB;
  const bf16*Qw=Q+(rowbase+q0+wid*QBLK)*DM+h*D;
  const bf16*Kh=K+rowbase*DM+h*D,*Vh=V+rowbase*DM+h*D;
  const unsigned lds0=(unsigned)(uintptr_t)shm;
  float*wsf=(float*)(shm+LDS_WS)+wid*64;
  const bf16*ksrc=Kh+(long)lane*DM+wid*8;
  const bf16*vsrc=Vh+(long)(16*(wid&3)+(lane>>2))*DM+(wid>>2)*32+(lane&3)*8;
  const unsigned kdst=lds0+LDS_K+wid*1024, vdst=lds0+LDS_V+wid*1024;
  #define DMA_K(t,slot) glds16(ksrc+(long)(t)*KVBLK*DM,(unsigned)__builtin_amdgcn_readfirstlane(kdst+(slot)))
  #define DMA_V(t,slot) glds16(vsrc+(long)(t)*KVBLK*DM,(unsigned)__builtin_amdgcn_readfirstlane(vdst+(slot)))
  const int vb0=(int)(lds0+LDS_V)+((lane>>4)&1)*32+(lane&3)*8+(4*hi+((lane&15)>>2))*64;
  const char*Kbase=shm+LDS_K; bf16x8 kf[8];
  const lds_cptr shm3=(lds_cptr)shm; const lds_cptr kp0=shm3+LDS_K+hi*1024+r32*16; const lds_cptr vp0=shm3+LDS_V+((lane>>4)&1)*32+(lane&3)*8+(4*hi+((lane&15)>>2))*64;
  const int NT=(q0+QB)/KVBLK;
  { const float*Fg=Fp+((long)b*NHEAD+h)*SEQ; float*Fl=(float*)(shm+LDS_F);
    for(int i=tid*4;i<q0+QB;i+=NW*64*4)*(f32x4v*)(Fl+i)=*(const f32x4v*)(Fg+i); }
  const lds_cptr fl3=shm3+LDS_F+hi*16;
  DMA_K(0,0);DMA_V(0,0);DMA_K(1,SLOTB);
  bf16x8 qr[4];
  #pragma unroll
  for(int d0=0;d0<4;++d0)qr[d0]=*reinterpret_cast<const bf16x8*>(&Qw[(long)r32*DM+d0*16+hi*8]);
  float mhat=0.f,l_reg=0.f,aq=0.f,fqv=0.f;f32x16 o[2];o[0]=f32x16{};o[1]=f32x16{};
  const int qrel=wid*QBLK+r32;
  #define CMASK(P0,P1,t) do{int jb_=(t)-(NT-4); if(jb_>=0)cmask(P0,P1,jb_,qrel,hi);}while(0)
  bool resc=false;
  #define START(P0,P1) do{ const float rm=rowmax(P0,P1); resc=false; \
    { const float dl=rm; mhat=fadd_s(mhat,dl); \
      _Pragma("unroll") for(int r=0;r<16;++r){P0[r]=fsub_s(P0[r],dl);P1[r]=fsub_s(P1[r],dl);} \
      aq=fqv-mhat; } \
    _Pragma("unroll") for(int r=0;r<16;++r)P0[r]=__builtin_amdgcn_exp2f(P0[r]); }while(0)
  #define RESC() do{ if(resc){ asm volatile("s_waitcnt lgkmcnt(0)":::"memory"); \
      _Pragma("unroll") for(int d_=0;d_<2;++d_) _Pragma("unroll") for(int r=0;r<16;++r)o[d_][r]*=wsf[crow(r,hi)]; } }while(0)
  f32x16 pA0,pA1,pB0,pB1;
  #define BLD(X0,X1,tt) do{ const lds_cptr fp_=fl3+(tt)*256; _Pragma("unroll") for(int j_=0;j_<4;++j_){ const f32x4v a_=*(const __attribute__((address_space(3))) f32x4v*)(fp_+j_*32); const f32x4v b_=*(const __attribute__((address_space(3))) f32x4v*)(fp_+j_*32+128); \
      X0[4*j_]=a_[0];X0[4*j_+1]=a_[1];X0[4*j_+2]=a_[2];X0[4*j_+3]=a_[3]; X1[4*j_]=b_[0];X1[4*j_+1]=b_[1];X1[4*j_+2]=b_[2];X1[4*j_+3]=b_[3]; } }while(0)
  #define BSUB(X0,X1) do{ _Pragma("unroll") for(int r_=0;r_<16;++r_){X0[r_]=aq-X0[r_];X1[r_]=aq-X1[r_];} }while(0)
  int sl_prev=0,sl_cur=0,sl_next=SLOTB;
  #define ROT() do{sl_prev=sl_cur;sl_cur=sl_next;sl_next=(sl_next==(NSLOT-1)*SLOTB)?0:sl_next+SLOTB;}while(0)
  DMA_K(2,2*SLOTB);
  WAIT_BAR(3);
  fqv=*(const __attribute__((address_space(3))) float*)(shm3+LDS_F+(q0+wid*QBLK+r32)*4); aq=fqv;
  BLD(pA0,pA1,0); BSUB(pA0,pA1);
  qkt(pA0,pA1,Kbase,qr,r32,hi);asm volatile("s_nop 15\n\ts_nop 7":"+v"(pA0),"+v"(pA1));CMASK(pA0,pA1,0);
  START(pA0,pA1);
  _Pragma("unroll") for(int r=0;r<16;++r)pA1[r]=__builtin_amdgcn_exp2f(pA1[r]);
  BLD(pB0,pB1,1); BSUB(pB0,pB1);
  WAIT_BAR(0);
  DMA_K(3,0);DMA_V(1,SLOTB);
  ROT();
  kload8(kf,kp0+sl_cur);
  WAIT_BAR(2);
  s16x4 vlo[8],vhi[8]; u32x4 pw0,pw1,pw2,pw3;
  #define PKW(P,B) cvtpk_s(P[B],P[B+1])
  #define PAF(k) __builtin_bit_cast(bf16x8,pw##k)
  #define VFR(i) (bf16x8){vlo[i][0],vlo[i][1],vlo[i][2],vlo[i][3],vhi[i][0],vhi[i][1],vhi[i][2],vhi[i][3]}
  #define PIN(x) asm volatile("":"+v"(x))
  #define MX3(a,b,c) __builtin_fmaxf(__builtin_fmaxf((a),(b)),(c))
  #define GAPA(MF,A0,A1,A2,A3,W0,W1,PW) do{ MF; sacc+=A0; sacc+=A1; sacc+=A2; sacc+=A3; PIN(sacc); W0; W1; PIN(PW); SBAR(); }while(0)
  #define EX(v) __builtin_amdgcn_exp2f(v)
  #define GAPB(MF,X,B) do{ MF; X[B]=EX(X[B]); X[B+1]=EX(X[B+1]); X[B+2]=EX(X[B+2]); X[B+3]=EX(X[B+3]); PIN(X); SBAR(); }while(0)
  #define VRD(i) do{ vlo[i]=vtr(vp_+(((i)>>2)*4096+((i)&3)*1024)); vhi[i]=vtr(vp_+(((i)>>2)*4096+((i)&3)*1024+512)); }while(0)
  #define KRD(G,j) do{ if(G){ kload2(kf,kp0+sl_next,j); SBAR(); } }while(0)
  #define STEP(C0,C1,P0,P1,t,GK,GV,GL) do{ SBAR(); \
    const lds_cptr vp_=vp0+sl_prev; \
    VRD(0); SBAR(); float sacc=(P0[0]+P0[1]); \
    GAPA(C0=__builtin_amdgcn_mfma_f32_32x32x16_bf16(kf[0],qr[0],C0,0,0,0), P0[2],P0[3],P0[4],P0[5],     pw0[0]=PKW(P0,0), pw0[1]=PKW(P0,2), pw0); \
    VRD(4); SBAR(); GAPA(C1=__builtin_amdgcn_mfma_f32_32x32x16_bf16(kf[1],qr[0],C1,0,0,0), P0[6],P0[7],P0[8],P0[9],     pw0[2]=PKW(P0,4), pw0[3]=PKW(P0,6), pw0); \
    VRD(1); SBAR(); GAPA(C0=__builtin_amdgcn_mfma_f32_32x32x16_bf16(kf[2],qr[1],C0,0,0,0),   P0[10],P0[11],P0[12],P0[13], pw1[0]=PKW(P0,8), pw1[1]=PKW(P0,10), pw1); \
    VRD(5); SBAR(); GAPA(C1=__builtin_amdgcn_mfma_f32_32x32x16_bf16(kf[3],qr[1],C1,0,0,0),   P0[14],P0[15],P1[0],P1[1],   pw1[2]=PKW(P0,12),pw1[3]=PKW(P0,14), pw1); \
    VRD(2); SBAR(); GAPA(C0=__builtin_amdgcn_mfma_f32_32x32x16_bf16(kf[4],qr[2],C0,0,0,0),   P1[2],P1[3],P1[4],P1[5],     pw2[0]=PKW(P1,0), pw2[1]=PKW(P1,2), pw2); \
    VRD(6); SBAR(); GAPA(C1=__builtin_amdgcn_mfma_f32_32x32x16_bf16(kf[5],qr[2],C1,0,0,0),   P1[6],P1[7],P1[8],P1[9],     pw2[2]=PKW(P1,4), pw2[3]=PKW(P1,6), pw2); \
    VRD(3); SBAR(); GAPA(C0=__builtin_amdgcn_mfma_f32_32x32x16_bf16(kf[6],qr[3],C0,0,0,0),   P1[10],P1[11],P1[12],P1[13], pw3[0]=PKW(P1,8), pw3[1]=PKW(P1,10), pw3); \
    VRD(7); SBAR(); GAPA(C1=__builtin_amdgcn_mfma_f32_32x32x16_bf16(kf[7],qr[3],C1,0,0,0),   P1[14],P1[15],0.f,0.f,       pw3[2]=PKW(P1,12),pw3[3]=PKW(P1,14), pw3); \
    l_reg+=sacc; \
    if(GK){DMA_K((t)+3,sl_cur);} if(GV){DMA_V((t)+1,sl_next);} \
    CMASK(C0,C1,t); \
    { float a=MX3(C0[0],C0[1],C1[0]),b=MX3(C0[2],C0[3],C1[1]); a=MX3(a,C1[2],C1[3]); \
      _Pragma("unroll") for(int r=4;r<16;r+=4){a=MX3(a,C0[r],C0[r+1]);b=MX3(b,C0[r+2],C0[r+3]);a=MX3(a,C1[r],C1[r+1]);b=MX3(b,C1[r+2],C1[r+3]);} \
      float rm=__builtin_fmaxf(a,b); { auto rr=__builtin_amdgcn_permlane32_swap(__float_as_uint(rm),__float_as_uint(rm),false,false); rm=__builtin_fmaxf(__uint_as_float(rr[0]),__uint_as_float(rr[1])); } \
      resc=false; \
      if(__builtin_expect(__any(rm>(float)THRL),0)){ const float dl=__builtin_fmaxf(rm,0.f); mhat+=dl; \
        _Pragma("unroll") for(int r=0;r<16;++r){C0[r]-=dl;C1[r]-=dl;} \
        aq=fqv-mhat; \
        const float f=__builtin_amdgcn_exp2f(-dl); l_reg*=f; if(hi==0)wsf[r32]=f; resc=true; } } \
    SBAR(); \
    if(GL){ BLD(P0,P1,(t)+1); SBAR(); } \
    GAPB(o[0]=__builtin_amdgcn_mfma_f32_32x32x16_bf16(PAF(0),VFR(0),o[0],0,0,0), C0,0); \
    GAPB(o[1]=__builtin_amdgcn_mfma_f32_32x32x16_bf16(PAF(0),VFR(4),o[1],0,0,0), C0,4); \
    KRD(GL,0); GAPB(o[0]=__builtin_amdgcn_mfma_f32_32x32x16_bf16(PAF(1),VFR(1),o[0],0,0,0), C0,8); \
    KRD(GL,1); GAPB(o[1]=__builtin_amdgcn_mfma_f32_32x32x16_bf16(PAF(1),VFR(5),o[1],0,0,0), C0,12); \
    KRD(GL,2); GAPB(o[0]=__builtin_amdgcn_mfma_f32_32x32x16_bf16(PAF(2),VFR(2),o[0],0,0,0), C1,0); \
    KRD(GL,3); GAPB(o[1]=__builtin_amdgcn_mfma_f32_32x32x16_bf16(PAF(2),VFR(6),o[1],0,0,0), C1,4); \
    GAPB(o[0]=__builtin_amdgcn_mfma_f32_32x32x16_bf16(PAF(3),VFR(3),o[0],0,0,0), C1,8); \
    GAPB(o[1]=__builtin_amdgcn_mfma_f32_32x32x16_bf16(PAF(3),VFR(7),o[1],0,0,0), C1,12); \
    if(GL){ BSUB(P0,P1); SBAR(); } \
    }while(0)
  int t=1;
  #undef CMASK
  #define CMASK(P0,P1,t) do{}while(0)
  for(;t+5<NT;t+=2){
    STEP(pB0,pB1,pA0,pA1,t,true,true,true);     WAIT_BAR(2); RESC(); ROT();
    STEP(pA0,pA1,pB0,pB1,t+1,true,true,true);   WAIT_BAR(2); RESC(); ROT();
  }
  #undef CMASK
  #define CMASK(P0,P1,t) do{int jb_=(t)-(NT-4); if(jb_>=0)cmask(P0,P1,jb_,qrel,hi);}while(0)
  #define ENDW(tt) do{ if((tt)+3<NT){WAIT_BAR(2);} else if((tt)+2<NT){WAIT_BAR(1);} else {WAIT_BAR(0);} }while(0)
  for(;t+1<NT;t+=2){
    STEP(pB0,pB1,pA0,pA1,t,(t+3<NT),(t+1<NT),(t+1<NT));       ENDW(t);   RESC(); ROT();
    STEP(pA0,pA1,pB0,pB1,t+1,(t+4<NT),(t+2<NT),(t+2<NT));     ENDW(t+1); RESC(); ROT();
  }
  STEP(pB0,pB1,pA0,pA1,NT-1,false,false,false); RESC();
  { float sacc=pB0[0]+pB0[1]; _Pragma("unroll") for(int r=2;r<16;++r)sacc+=pB0[r]; _Pragma("unroll") for(int r=0;r<16;++r)sacc+=pB1[r]; l_reg+=sacc;
    pw0=(u32x4){PKW(pB0,0),PKW(pB0,2),PKW(pB0,4),PKW(pB0,6)};pw1=(u32x4){PKW(pB0,8),PKW(pB0,10),PKW(pB0,12),PKW(pB0,14)};pw2=(u32x4){PKW(pB1,0),PKW(pB1,2),PKW(pB1,4),PKW(pB1,6)};pw3=(u32x4){PKW(pB1,8),PKW(pB1,10),PKW(pB1,12),PKW(pB1,14)};
    SBAR(); pv(o,vb0+sl_cur,PAF(0),PAF(1),PAF(2),PAF(3)); }
  #undef PKW
  #undef PAF
  #undef VFR
  #undef PIN
  #undef MX3
  #undef GAPA
  #undef GAPB
  #undef EX
  #undef VRD
  #undef KRD
  #undef STEP
  #undef ENDW
  {auto rr=__builtin_amdgcn_permlane32_swap(__float_as_uint(l_reg),__float_as_uint(l_reg),false,false);l_reg=__uint_as_float(rr[0])+__uint_as_float(rr[1]);}
  if(hi==0)wsf[32+r32]=l_reg;asm volatile("s_waitcnt lgkmcnt(0)":::"memory");
  float rli[16];
  #pragma unroll
  for(int r=0;r<16;++r)rli[r]=__builtin_amdgcn_rcpf(wsf[32+crow(r,hi)]);
  bf16*Ow=O+(rowbase+q0+wid*QBLK)*DMO+h*D;
  { bf16*stg=(bf16*)(shm+LDS_OST)+wid*2048;
    #pragma unroll
    for(int r=0;r<16;++r){const int orow=crow(r,hi);
      #pragma unroll
      for(int d0=0;d0<2;++d0)stg[orow*64+d0*32+r32]=__float2bfloat16(o[d0][r]*rli[r]);}
    asm volatile("s_waitcnt lgkmcnt(0)":::"memory");
    #pragma unroll
    for(int i=0;i<4;++i){const int row=i*8+(lane>>3),ch=lane&7; const u32x4 v=*(const u32x4*)(stg+row*64+ch*8); ATTN_STORE16(Ow+(long)row*DMO+ch*8,v);} }
  asm volatile("s_waitcnt lgkmcnt(0)\n\ts_barrier":::"memory");
  #undef BLD
  #undef BSUB
  #undef DMA_K
  #undef DMA_V
  #undef CMASK
  #undef START
  #undef RESC
  #undef ROT
}
constexpr int ATTN_LDS_BYTES=LDS_BYTES;
struct AttnTensors { const bf16* Q; const bf16* K; const bf16* V; bf16* O; const float* F; };
struct AttnUnit { int bh; int qb; };
struct StaticOrder {
  int vcu;
  __device__ __forceinline__ explicit StaticOrder(int grid,int block):vcu((block%8)*(grid/8)+block/8){}
  __device__ __forceinline__ bool next(int i,AttnUnit&u)const{ if(i>=2||vcu>=256)return false; const int s=vcu&7; u.bh=vcu>>3; u.qb=(i==0)?15-s:s; return true; }
  __device__ __forceinline__ void a_ready(const AttnUnit&)const{}
  __device__ __forceinline__ void done(const AttnUnit&)const{}
};
template<class Sched,int THRL=8> __device__ __forceinline__ void attn_phase(char*lds,const AttnTensors&T,const Sched&S){
  AttnUnit u;
  for(int i=0;S.next(i,u);++i){ S.a_ready(u); attn_unit<THRL>(u.bh/NHEAD,u.bh%NHEAD,u.qb,T.Q,T.K,T.V,T.O,T.F,lds); S.done(u); }
}
#undef SBAR
#undef WAIT_BAR
}
constexpr int NWAVES = 8;
#ifndef MK_N_LAUNCHES
#define MK_N_LAUNCHES 1
#endif
constexpr int N_PHASES = 11;
constexpr int N_LAUNCHES = MK_N_LAUNCHES;
static_assert(N_LAUNCHES == 1 || N_LAUNCHES == N_PHASES, "MK_N_LAUNCHES is 1 or 11");

constexpr int BATCH = 4, SEQ = 4096, D = 1024, M = BATCH * SEQ, NMEM = 256, MMEM = BATCH * NMEM, FF = 4096;
constexpr int INC = 3592, NIN = 3584;
constexpr int FOXH = 8, HGH = 4, CH = 64, NCH = SEQ / CH, NUNIT = BATCH * HGH * NCH;
constexpr float EPS = 1e-6f;
constexpr float LOG2E = 1.4426950408889634f;

constexpr size_t MiB = 1u << 20;
constexpr size_t WS_CTL = 0, CTL_ZERO_BYTES = 64 * 1024;
constexpr size_t WS_LOGF = 1 * MiB;
constexpr size_t WS_FCUM = WS_LOGF + MiB / 2;
constexpr size_t WS_DEC = 2 * MiB;
constexpr size_t WS_SS = 2 * MiB + MiB / 2;
constexpr size_t WS_MEMN = 4 * MiB, WS_KMEM = 6 * MiB, WS_VMEM = 8 * MiB, WS_WKT = 10 * MiB, WS_VWT = 18 * MiB;
constexpr size_t WS_WIN = 26 * MiB, WS_WXKV = 33 * MiB, WS_WOUT = 37 * MiB, WS_WQ = 39 * MiB, WS_WXO = 41 * MiB, WS_W1 = 43 * MiB, WS_W2 = 51 * MiB;
constexpr size_t WS_XN = 60 * MiB;
constexpr size_t WS_AO = 92 * MiB;
constexpr size_t WS_Q = 124 * MiB, WS_K = 140 * MiB, WS_V = 156 * MiB, WS_GQ = 172 * MiB, WS_GI = 188 * MiB, WS_GG = 204 * MiB, WS_G = 220 * MiB;
constexpr size_t WS_H = 124 * MiB;
constexpr size_t WS_END = 252 * MiB;

constexpr int CW_BAR = 4096;
constexpr int RING_OFF = 0, RING_BYTES = 131072;
constexpr int LDSCTL_OFF = RING_BYTES, MISC_OFF = LDSCTL_OFF + 320;
constexpr int LDS_BYTES = 147456;
static_assert(MISC_OFF + 128 <= LDS_BYTES, "LDS map");

#define GAS __attribute__((address_space(1)))
#define LAS __attribute__((address_space(3)))
typedef unsigned short bf16;
typedef unsigned v4u __attribute__((ext_vector_type(4)));
typedef unsigned v2u __attribute__((ext_vector_type(2)));
typedef float f32x4 __attribute__((ext_vector_type(4)));
typedef float f32x2 __attribute__((ext_vector_type(2)));
typedef short bf16x8 __attribute__((ext_vector_type(8)));
typedef GAS unsigned gu32;
#define RLX_AGENT __ATOMIC_RELAXED, __HIP_MEMORY_SCOPE_AGENT
#define LDS_WAIT() asm volatile("s_waitcnt lgkmcnt(0)" ::: "memory")
#define VM_WAIT() asm volatile("s_waitcnt vmcnt(0)" ::: "memory")
__device__ __forceinline__ unsigned f2bf(float f) { unsigned u = __builtin_bit_cast(unsigned, f); return (u + 0x7fffu + ((u >> 16) & 1u)) >> 16; }
__device__ __forceinline__ unsigned pk2(float lo, float hi) { return f2bf(lo) | (f2bf(hi) << 16); }
__device__ __forceinline__ float bf2f(unsigned short b) { return __builtin_bit_cast(float, (unsigned)b << 16); }
#define XB_TMO      128
#define XB_XCNT(j)  (256  + 64 * (j))
#define XB_XSUB(j)  (1280 + 64 * (j))
#define XB_XGEN(j)  (2304 + 64 * (j))
#define XB_TOP      3328
#define XB_TOPGEN   3392
#define XCD_BAR_WORDS 3456
#define XB_SPIN_CAP (1u << 18)

__device__ __forceinline__ unsigned xb_ld(unsigned* p)              { return __hip_atomic_load(p, __ATOMIC_RELAXED, __HIP_MEMORY_SCOPE_AGENT); }
__device__ __forceinline__ unsigned xb_add(unsigned* p, unsigned v) { return __hip_atomic_fetch_add(p, v, __ATOMIC_RELAXED, __HIP_MEMORY_SCOPE_AGENT); }
__device__ __forceinline__ unsigned xb_xcc_id() { return (unsigned)__builtin_amdgcn_s_getreg((3 << 11) | 20) & 0xFu; }
#define XB_SPIN(cond, bar) do { unsigned _sp = 0; while (cond) { __builtin_amdgcn_s_sleep(1); \
    if ((++_sp & 255u) == 0u) { if (xb_ld(&(bar)[XB_TMO])) break; if (_sp > XB_SPIN_CAP) { atomicAdd(&(bar)[XB_TMO], 1u); break; } } } } while (0)

struct XcdBarrier {
    unsigned* bar; unsigned x;
    volatile LAS unsigned* st;
};

__device__ __forceinline__ XcdBarrier xcd_barrier_post(unsigned* bar, volatile LAS unsigned* st) {
    XcdBarrier b; b.bar = bar; b.x = xb_xcc_id(); b.st = st;
    if (threadIdx.x == 0) (void)xb_add(&bar[XB_XCNT(b.x)], 1u);
    return b;
}
__device__ __forceinline__ void xcd_barrier_complete(unsigned* bar, unsigned x, unsigned& nloc, unsigned& nx) {
    const unsigned G = gridDim.x * gridDim.y * gridDim.z;
    unsigned sum, cnt, mine, sp = 0u;
    for (;;) {
        sum = 0u; cnt = 0u; mine = 0u;
#pragma unroll
        for (unsigned j = 0; j < 16; ++j) { const unsigned c = xb_ld(&bar[XB_XCNT(j)]); sum += c; cnt += (c > 0u) ? 1u : 0u; mine = (j == x) ? c : mine; }
        if (sum == G) break;
        __builtin_amdgcn_s_sleep(1);
        if ((++sp & 255u) == 0u) { if (xb_ld(&bar[XB_TMO])) break; if (sp > XB_SPIN_CAP) { atomicAdd(&bar[XB_TMO], 1u); break; } }
    }
    nloc = mine > 0u ? mine : 1u; nx = cnt > 0u ? cnt : 1u;
}

__device__ __forceinline__ void xcd_barrier(const XcdBarrier& b) {
    asm volatile("s_waitcnt vmcnt(0)" ::: "memory");
    __syncthreads();
    if (threadIdx.x == 0) {
        unsigned* bar = b.bar;
        __builtin_amdgcn_s_waitcnt(0);
        unsigned nloc = b.st[0], nx = b.st[1];
        if (nloc == 0u) { xcd_barrier_complete(bar, b.x, nloc, nx); b.st[0] = nloc; b.st[1] = nx; }
        const unsigned old = xb_add(&bar[XB_XSUB(b.x)], 1u);
        const unsigned gen = old / nloc;
        if (old + 1u == (gen + 1u) * nloc) {
            __builtin_amdgcn_fence(__ATOMIC_RELEASE, "agent");
            asm volatile("s_waitcnt vmcnt(0)" ::: "memory");
            const unsigned og = xb_add(&bar[XB_TOP], 1u);
            const unsigned tg = og / nx;
            if (og + 1u == (tg + 1u) * nx) xb_add(&bar[XB_TOPGEN], 1u);
            else XB_SPIN(xb_ld(&bar[XB_TOPGEN]) == tg, bar);
            __builtin_amdgcn_fence(__ATOMIC_ACQUIRE, "agent");
            xb_add(&bar[XB_XGEN(b.x)], 1u);
            asm volatile("s_waitcnt vmcnt(0)" ::: "memory");
        } else {
            XB_SPIN(xb_ld(&bar[XB_XGEN(b.x)]) == gen, bar);
            __builtin_amdgcn_fence(__ATOMIC_ACQUIRE, "agent");
            asm volatile("s_waitcnt vmcnt(0)" ::: "memory");
        }
    }
    __syncthreads();
}
struct Frame {
    LAS unsigned char* lds;
    volatile LAS unsigned* MISC;
    gu32* ctl;
    int tid, lane, wave;
    int vcu, G;
    const float* in[17]; float* out; unsigned char* ws;
};
__device__ __forceinline__ float wave_sum(float v) {
#pragma unroll
    for (int o = 1; o < 64; o <<= 1) v += __shfl_xor(v, o);
    return v;
}
__device__ __forceinline__ void p0_transpose_item(const float* W, int ldw, int src_off, int ncols, int K, bf16* WT, int row_off, const float* gk, LAS float* scr, int item, int lane) {
    const int nblk = ncols / 32, kb = item / nblk, nb = item % nblk, k0 = 64 * kb, n0 = 32 * nb;
#pragma unroll 8
    for (int i = 0; i < 32; ++i) { const int kk = 2 * i + (lane >> 5); float w = W[(size_t)(k0 + kk) * ldw + src_off + n0 + (lane & 31)]; if (gk) w *= gk[k0 + kk]; scr[kk * 33 + (lane & 31)] = w; }
    LDS_WAIT(); asm volatile("" ::: "memory");
    const int c = lane & 7;
#pragma unroll
    for (int j = 0; j < 4; ++j) { const int n = (lane >> 3) + 8 * j; const LAS float* s = scr + (8 * c) * 33 + n;
        v4u o; o.x = pk2(s[0 * 33], s[1 * 33]); o.y = pk2(s[2 * 33], s[3 * 33]); o.z = pk2(s[4 * 33], s[5 * 33]); o.w = pk2(s[6 * 33], s[7 * 33]);
        *(GAS v4u*)(WT + (size_t)(row_off + n0 + n) * K + k0 + 8 * c) = o; }
    LDS_WAIT(); asm volatile("" ::: "memory");
}
__device__ __forceinline__ void p0_prologue(Frame& F) {
    constexpr int SCR_STRIDE = 8704;
    LAS float* scr = (LAS float*)(F.lds + RING_OFF + F.wave * SCR_STRIDE);
    LAS float* Wf = (LAS float*)(F.lds + RING_OFF + 8 * SCR_STRIDE);
    const float* x = F.in[0]; const float* mem = F.in[1]; const float* gmix = F.in[2]; const float* w_in = F.in[3]; const float* fbias = F.in[4];
    bf16* XN = (bf16*)(F.ws + WS_XN); bf16* MEMN = (bf16*)(F.ws + WS_MEMN); float* LOGF = (float*)(F.ws + WS_LOGF);
    for (int k = F.tid; k < 1024; k += NWAVES * 64) { const f32x4* p = (const f32x4*)(w_in + (size_t)k * INC + 1536); const int sl = ((k & 3) * 4 + (k >> 8)) * 64 + ((k >> 2) & 63); *(LAS f32x4*)(Wf + sl * 8) = p[0]; *(LAS f32x4*)(Wf + sl * 8 + 4) = p[1]; }
    __syncthreads();
    const int gw = F.vcu * NWAVES + F.wave, NGW = F.G * NWAVES;
    for (int m = gw; m < M; m += NGW) {
        const GAS f32x4* xr = (const GAS f32x4*)(x + (size_t)m * D) + F.lane; const GAS f32x4* gr = (const GAS f32x4*)gmix + F.lane;
        f32x4 v[4]; float s = 0.f;
#pragma unroll
        for (int j = 0; j < 4; ++j) { v[j] = xr[64 * j]; s += (v[j].x * v[j].x + v[j].y * v[j].y) + (v[j].z * v[j].z + v[j].w * v[j].w); }
        const float rstd = 1.0f / sqrtf(wave_sum(s) * (1.f / D) + EPS);
        float ff[8];
#pragma unroll
        for (int h = 0; h < 8; ++h) ff[h] = 0.f;
        GAS v2u* o8 = (GAS v2u*)(XN + (size_t)m * D) + F.lane;
#pragma unroll
        for (int j = 0; j < 4; ++j) { const f32x4 g = gr[64 * j]; const f32x4 hn = v[j] * rstd * g;
            v2u w; w.x = pk2(hn.x, hn.y); w.y = pk2(hn.z, hn.w); o8[64 * j] = w;
#pragma unroll
            for (int e = 0; e < 4; ++e) { const LAS float* wf = Wf + ((e * 4 + j) * 64 + F.lane) * 8; const f32x4 w0 = *(const LAS f32x4*)wf, w1 = *(const LAS f32x4*)(wf + 4);
                ff[0] += hn[e] * w0[0]; ff[1] += hn[e] * w0[1]; ff[2] += hn[e] * w0[2]; ff[3] += hn[e] * w0[3]; ff[4] += hn[e] * w1[0]; ff[5] += hn[e] * w1[1]; ff[6] += hn[e] * w1[2]; ff[7] += hn[e] * w1[3]; } }
        float mine = 0.f;
#pragma unroll
        for (int h = 0; h < 8; ++h) { const float t = wave_sum(ff[h]); if (F.lane == h) mine = t; }
        if (F.lane < 8) { const float z = mine + fbias[F.lane]; LOGF[(size_t)m * 8 + F.lane] = fminf(z, 0.f) - log1pf(expf(-fabsf(z))); }
    }
    for (int m = gw; m < MMEM; m += NGW) {
        const GAS f32x4* xr = (const GAS f32x4*)(mem + (size_t)m * D) + F.lane; const GAS f32x4* gr = (const GAS f32x4*)F.in[9] + F.lane;
        f32x4 v[4]; float s = 0.f;
#pragma unroll
        for (int j = 0; j < 4; ++j) { v[j] = xr[64 * j]; s += (v[j].x * v[j].x + v[j].y * v[j].y) + (v[j].z * v[j].z + v[j].w * v[j].w); }
        const float rstd = 1.0f / sqrtf(wave_sum(s) * (1.f / D) + EPS);
        GAS v2u* o8 = (GAS v2u*)(MEMN + (size_t)m * D) + F.lane;
#pragma unroll
        for (int j = 0; j < 4; ++j) { const f32x4 hn = v[j] * rstd * gr[64 * j]; v2u w; w.x = pk2(hn.x, hn.y); w.y = pk2(hn.z, hn.w); o8[64 * j] = w; }
    }
    { const float* wq = F.in[10]; const float* gx = F.in[8]; bf16* WQ = (bf16*)(F.ws + WS_WQ);
      for (int k = gw; k < D; k += NGW) { const float g = gx[k]; const GAS f32x4* r = (const GAS f32x4*)(wq + (size_t)k * D) + F.lane; GAS v2u* o8 = (GAS v2u*)(WQ + (size_t)k * D) + F.lane;
#pragma unroll
          for (int j = 0; j < 4; ++j) { const f32x4 w = r[64 * j] * g; v2u p; p.x = pk2(w.x, w.y); p.y = pk2(w.z, w.w); o8[64 * j] = p; } } }
    constexpr int I_A = 16 * 48, I_B = 16 * 64, I_KV = 16 * 64, I_O = 16 * 32, I_XO = 16 * 32, I_1 = 16 * 128, I_2 = 64 * 32;
    constexpr int NITEMS = I_A + I_B + I_KV + I_O + I_XO + I_1 + I_2;
    for (int it = gw; it < NITEMS; it += NGW) {
        int r = it;
        if (r < I_A) { p0_transpose_item(w_in, INC, 0, 1536, D, (bf16*)(F.ws + WS_WIN), 0, nullptr, scr, r, F.lane); continue; } r -= I_A;
        if (r < I_B) { p0_transpose_item(w_in, INC, 1544, 2048, D, (bf16*)(F.ws + WS_WIN), 1536, nullptr, scr, r, F.lane); continue; } r -= I_B;
        if (r < I_KV) { p0_transpose_item(F.in[11], 2 * D, 0, 2 * D, D, (bf16*)(F.ws + WS_WXKV), 0, nullptr, scr, r, F.lane); continue; } r -= I_KV;
        if (r < I_O) { p0_transpose_item(F.in[7], D, 0, D, D, (bf16*)(F.ws + WS_WOUT), 0, nullptr, scr, r, F.lane); continue; } r -= I_O;
        if (r < I_XO) { p0_transpose_item(F.in[12], D, 0, D, D, (bf16*)(F.ws + WS_WXO), 0, nullptr, scr, r, F.lane); continue; } r -= I_XO;
        if (r < I_1) { p0_transpose_item(F.in[14], FF, 0, FF, D, (bf16*)(F.ws + WS_W1), 0, F.in[13], scr, r, F.lane); continue; } r -= I_1;
        p0_transpose_item(F.in[15], D, 0, D, FF, (bf16*)(F.ws + WS_W2), 0, nullptr, scr, r, F.lane);
    }
    __syncthreads();
}
__device__ __forceinline__ void fcumsum(Frame& F, int bh) {
    const float* LOGF = (const float*)(F.ws + WS_LOGF); float* FC = (float*)(F.ws + WS_FCUM);
    LAS double* wt = (LAS double*)(F.lds + RING_OFF);
    const int b = bh >> 3, h = bh & 7, s0 = F.tid * 8;
    double v[8]; double run = 0.0;
#pragma unroll
    for (int i = 0; i < 8; ++i) { run += (double)LOGF[((size_t)b * SEQ + s0 + i) * 8 + h]; v[i] = run; }
    double inc = run;
#pragma unroll
    for (int o = 1; o < 64; o <<= 1) { const double t = __shfl_up(inc, o); if (F.lane >= o) inc += t; }
    if (F.lane == 63) wt[F.wave] = inc;
    __syncthreads();
    double base = inc - run;
    for (int w = 0; w < F.wave; ++w) base += wt[w];
#pragma unroll
    for (int i = 0; i < 8; ++i) FC[(size_t)bh * SEQ + s0 + i] = (float)((base + v[i]) * (double)LOG2E);
    __syncthreads();
}
constexpr int P72 = 72, P136 = 136;
#define HG_FRAG(base, row, pitch, kk) (*(const LAS bf16x8*)((base) + ((row) * (pitch) + (kk)) ))
__device__ __forceinline__ void hg_it_task(const bf16* GI, int row0, int hc, LAS bf16* IT, int task) {
    const int vp = task & 63, sb = task >> 6, v = 2 * vp, s0 = 8 * sb;
    unsigned w[8];
#pragma unroll
    for (int j = 0; j < 8; ++j) w[j] = *(const GAS unsigned*)(GI + (size_t)(row0 + s0 + j) * 512 + hc + v);
    v4u lo, hi;
    lo.x = (w[0] & 0xffffu) | (w[1] << 16); lo.y = (w[2] & 0xffffu) | (w[3] << 16); lo.z = (w[4] & 0xffffu) | (w[5] << 16); lo.w = (w[6] & 0xffffu) | (w[7] << 16);
    hi.x = (w[0] >> 16) | (w[1] & 0xffff0000u); hi.y = (w[2] >> 16) | (w[3] & 0xffff0000u); hi.z = (w[4] >> 16) | (w[5] & 0xffff0000u); hi.w = (w[6] >> 16) | (w[7] & 0xffff0000u);
    *(LAS v4u*)(IT + v * P72 + s0) = lo; *(LAS v4u*)(IT + (v + 1) * P72 + s0) = hi;
}
__device__ __forceinline__ void hg_local_states(Frame& F) {
    const float* G = (const float*)(F.ws + WS_G); const bf16* GI = (const bf16*)(F.ws + WS_GI); float* LT = F.out; float* DEC = (float*)(F.ws + WS_DEC);
    LAS bf16* KD = (LAS bf16*)(F.lds + RING_OFF);
    LAS bf16* IT = KD + 128 * P72;
    const int fr = F.lane & 15, fq = F.lane >> 4;
    for (int uid = F.vcu; uid < NUNIT; uid += F.G) {
        const int b = uid >> 8, h = (uid >> 6) & 3, c = uid & 63, row0 = b * SEQ + c * CH, hc = h * 128;
        if (F.tid < 128) {
            const int d = F.tid; float r = 0.f;
            for (int sb = 7; sb >= 0; --sb) {
                float gv[8];
#pragma unroll
                for (int j = 0; j < 8; ++j) gv[j] = G[(size_t)(row0 + sb * 8 + j) * 512 + hc + d];
                float kd[8];
#pragma unroll
                for (int j = 7; j >= 0; --j) { kd[j] = (1.0f - __expf(gv[j])) * __expf(r); r += gv[j]; }
                v4u o; o.x = pk2(kd[0], kd[1]); o.y = pk2(kd[2], kd[3]); o.z = pk2(kd[4], kd[5]); o.w = pk2(kd[6], kd[7]);
                *(LAS v4u*)(KD + d * P72 + sb * 8) = o;
            }
            DEC[(size_t)uid * 128 + d] = __expf(r);
        } else {
            for (int task = F.tid - 128; task < 512; task += 384) hg_it_task(GI, row0, hc, IT, task);
        }
        __syncthreads();
        f32x4 acc[8];
#pragma unroll
        for (int n = 0; n < 8; ++n) acc[n] = (f32x4){0.f, 0.f, 0.f, 0.f};
#pragma unroll
        for (int kk = 0; kk < 2; ++kk) { const bf16x8 a = HG_FRAG(IT, 16 * F.wave + fr, P72, 32 * kk + 8 * fq);
#pragma unroll
            for (int n = 0; n < 8; ++n) { const bf16x8 bq = HG_FRAG(KD, 16 * n + fr, P72, 32 * kk + 8 * fq); acc[n] = __builtin_amdgcn_mfma_f32_16x16x32_bf16(bq, a, acc[n], 0, 0, 0); } }
        float* lt = LT + (size_t)uid * 16384 + (size_t)(16 * F.wave + fr) * 128 + 4 * fq;
#pragma unroll
        for (int n = 0; n < 8; ++n) *(GAS f32x4*)(lt + 16 * n) = acc[n];
        __syncthreads();
    }
}
__device__ __forceinline__ void hg_scan(Frame& F) {
    const float* LT = F.out; const float* DEC = (const float*)(F.ws + WS_DEC); bf16* SP = (bf16*)(F.ws + WS_XN);
    for (int idx = F.vcu * (NWAVES * 64) + F.tid; idx < 16 * 128 * 64; idx += F.G * NWAVES * 64) {
        const int bh = idx >> 13, rem = idx & 8191, v = rem >> 6, d2 = (rem & 63) * 2;
        float s0 = 0.f, s1 = 0.f;
        for (int c0 = 0; c0 < NCH; c0 += 8) {
            f32x2 l[8], dc[8];
#pragma unroll
            for (int j = 0; j < 8; ++j) { const size_t uid = (size_t)bh * 64 + c0 + j; l[j] = *(const GAS f32x2*)(LT + uid * 16384 + v * 128 + d2); dc[j] = *(const GAS f32x2*)(DEC + uid * 128 + d2); }
#pragma unroll
            for (int j = 0; j < 8; ++j) { const size_t uid = (size_t)bh * 64 + c0 + j;
                *(GAS unsigned*)(SP + uid * 16384 + v * 128 + d2) = pk2(s0, s1);
                s0 = dc[j].x * s0 + l[j].x; s1 = dc[j].y * s1 + l[j].y; }
        }
    }
}
__device__ __forceinline__ void hg_outputs(Frame& F) {
    const float* G = (const float*)(F.ws + WS_G); const bf16* GQ = (const bf16*)(F.ws + WS_GQ); const bf16* GI = (const bf16*)(F.ws + WS_GI); const bf16* GG = (const bf16*)(F.ws + WS_GG);
    const bf16* SPg = (const bf16*)(F.ws + WS_XN); bf16* AO = (bf16*)(F.ws + WS_AO); const float* gn = F.in[6];
    LAS bf16* QT = (LAS bf16*)(F.lds + RING_OFF);
    LAS bf16* KT = QT + 64 * P136;
    LAS bf16* IT = KT + 64 * P136;
    LAS bf16* SP = IT + 128 * P72;
    LAS bf16* AT = SP + 128 * P136;
    LAS float* RS = (LAS float*)(AT + 64 * P72);
    const int fr = F.lane & 15, fq = F.lane >> 4, mt = F.wave & 3, nh = F.wave >> 2;
    for (int uid = F.vcu; uid < NUNIT; uid += F.G) {
        const int b = uid >> 8, h = (uid >> 6) & 3, c = uid & 63, row0 = b * SEQ + c * CH, hc = h * 128;
        if (F.tid < 128) {
            const int d = F.tid; float bc = 0.f;
            for (int sb = 0; sb < 8; ++sb) {
                float gv[8]; unsigned short qv[8];
#pragma unroll
                for (int j = 0; j < 8; ++j) { gv[j] = G[(size_t)(row0 + sb * 8 + j) * 512 + hc + d]; qv[j] = GQ[(size_t)(row0 + sb * 8 + j) * 512 + hc + d]; }
#pragma unroll
                for (int j = 0; j < 8; ++j) { bc += gv[j]; const int s = sb * 8 + j;
                    QT[s * P136 + d] = (bf16)f2bf(bf2f(qv[j]) * __expf(bc)); KT[s * P136 + d] = (bf16)f2bf((1.0f - __expf(gv[j])) * __expf(-bc)); }
            }
        } else {
            for (int task = F.tid - 128; task < 512; task += 384) hg_it_task(GI, row0, hc, IT, task);
            for (int ch = F.tid - 128; ch < 2048; ch += 384) { const int v = ch >> 4, cc = ch & 15; *(LAS v4u*)(SP + v * P136 + cc * 8) = *(const GAS v4u*)(SPg + (size_t)uid * 16384 + v * 128 + cc * 8); }
        }
        __syncthreads();
        {
            f32x4 a2[2] = {(f32x4){0.f, 0.f, 0.f, 0.f}, (f32x4){0.f, 0.f, 0.f, 0.f}};
#pragma unroll
            for (int kk = 0; kk < 4; ++kk) { const bf16x8 a = HG_FRAG(QT, 16 * mt + fr, P136, 32 * kk + 8 * fq);
#pragma unroll
                for (int n = 0; n < 2; ++n) { const bf16x8 bq = HG_FRAG(KT, 16 * (2 * nh + n) + fr, P136, 32 * kk + 8 * fq); a2[n] = __builtin_amdgcn_mfma_f32_16x16x32_bf16(bq, a, a2[n], 0, 0, 0); } }
            const int t = 16 * mt + fr;
#pragma unroll
            for (int n = 0; n < 2; ++n) { const int s = 16 * (2 * nh + n) + 4 * fq; v2u w;
                w.x = pk2(s <= t ? a2[n][0] : 0.f, s + 1 <= t ? a2[n][1] : 0.f); w.y = pk2(s + 2 <= t ? a2[n][2] : 0.f, s + 3 <= t ? a2[n][3] : 0.f);
                *(LAS v2u*)(AT + t * P72 + s) = w; }
        }
        __syncthreads();
        f32x4 acc[4];
#pragma unroll
        for (int n = 0; n < 4; ++n) acc[n] = (f32x4){0.f, 0.f, 0.f, 0.f};
#pragma unroll
        for (int kk = 0; kk < 2; ++kk) { const bf16x8 a = HG_FRAG(AT, 16 * mt + fr, P72, 32 * kk + 8 * fq);
#pragma unroll
            for (int n = 0; n < 4; ++n) { const bf16x8 bq = HG_FRAG(IT, 16 * (4 * nh + n) + fr, P72, 32 * kk + 8 * fq); acc[n] = __builtin_amdgcn_mfma_f32_16x16x32_bf16(bq, a, acc[n], 0, 0, 0); } }
#pragma unroll
        for (int kk = 0; kk < 4; ++kk) { const bf16x8 a = HG_FRAG(QT, 16 * mt + fr, P136, 32 * kk + 8 * fq);
#pragma unroll
            for (int n = 0; n < 4; ++n) { const bf16x8 bq = HG_FRAG(SP, 16 * (4 * nh + n) + fr, P136, 32 * kk + 8 * fq); acc[n] = __builtin_amdgcn_mfma_f32_16x16x32_bf16(bq, a, acc[n], 0, 0, 0); } }
        float q = 0.f;
#pragma unroll
        for (int n = 0; n < 4; ++n) q += (acc[n][0] * acc[n][0] + acc[n][1] * acc[n][1]) + (acc[n][2] * acc[n][2] + acc[n][3] * acc[n][3]);
        q += __shfl_xor(q, 16); q += __shfl_xor(q, 32);
        const int t = 16 * mt + fr;
        if (fq == 0) RS[t * 2 + nh] = q;
        __syncthreads();
        const float rstd = 1.0f / sqrtf((RS[t * 2] + RS[t * 2 + 1]) * (1.0f / 128.0f) + EPS);
#pragma unroll
        for (int n = 0; n < 4; ++n) { const int v = 16 * (4 * nh + n) + 4 * fq; const f32x4 g4 = *(const GAS f32x4*)(gn + v);
            const v2u gg = *(const GAS v2u*)(GG + (size_t)(row0 + t) * 512 + hc + v);
            const float o0 = acc[n][0] * rstd * g4[0] * bf2f((unsigned short)(gg.x & 0xffffu)), o1 = acc[n][1] * rstd * g4[1] * bf2f((unsigned short)(gg.x >> 16));
            const float o2 = acc[n][2] * rstd * g4[2] * bf2f((unsigned short)(gg.y & 0xffffu)), o3 = acc[n][3] * rstd * g4[3] * bf2f((unsigned short)(gg.y >> 16));
            v2u w; w.x = pk2(o0, o1); w.y = pk2(o2, o3); *(GAS v2u*)(AO + (size_t)(row0 + t) * 1024 + 512 + hc + v) = w; }
        __syncthreads();
    }
}
struct Args { const float* in[17]; float* out; unsigned char* ws; int ph_lo, ph_hi, li, pad; };
__global__ void __launch_bounds__(NWAVES * 64, 2) fwd_mega(Args args) {
    extern __shared__ __attribute__((aligned(16))) unsigned char lds[];
    Frame F;
    F.lds = (LAS unsigned char*)lds;
    F.MISC = (volatile LAS unsigned*)(F.lds + MISC_OFF);
    F.tid = threadIdx.x; F.lane = F.tid & 63; F.wave = __builtin_amdgcn_readfirstlane(F.tid >> 6);
    F.G = gridDim.x; { const int bx = blockIdx.x; F.vcu = (F.G % 8 == 0) ? (bx % 8) * (F.G / 8) + bx / 8 : bx; }
    F.ws = args.ws; F.out = args.out; F.ctl = (gu32*)(args.ws + WS_CTL);
#pragma unroll
    for (int i = 0; i < 17; ++i) F.in[i] = args.in[i];
    unsigned char* ws = args.ws;
    for (int u = F.tid; u < (LDS_BYTES - LDSCTL_OFF) / 4; u += NWAVES * 64) ((LAS unsigned*)(F.lds + LDSCTL_OFF))[u] = 0u;
    __syncthreads();
    XcdBarrier bar; bar.bar = (unsigned*)(F.ctl + CW_BAR); bar.x = 0; bar.st = nullptr;
    if (N_LAUNCHES == 1) bar = xcd_barrier_post((unsigned*)(F.ctl + CW_BAR), F.MISC + 8);
#define GRID_BAR() do { if (N_LAUNCHES == 1) xcd_barrier(bar); } while (0)
    const int lo = args.ph_lo, hi = args.ph_hi;
#define IN(k) (lo <= (k) && (k) < hi)
#define BOTH(k) (IN(k) && IN((k) + 1))
    const int cb = (int)blockIdx.x;
    float* SS = (float*)(ws + WS_SS);
    bf16* XB = (bf16*)(ws + WS_XN); bf16* AO = (bf16*)(ws + WS_AO);

    if (IN(0)) { p0_prologue(F); if (BOTH(0)) GRID_BAR(); }

    if (IN(1)) {
        if (cb >= 160 && cb < 192) fcumsum(F, cb - 160);
        { pg8::Gemm g{(const pg8::bf16_t*)(ws + WS_XN), (const pg8::bf16_t*)(ws + WS_WIN), D, D}; pg8::StaticOrder S; S.init(M, NIN, F.G, cb);
          pg8::EpiIn E; E.Ob = (pg8::bf16_t*)(ws + WS_Q); E.ostride = (size_t)(WS_K - WS_Q) / 2;
          static_assert(WS_V - WS_K == WS_K - WS_Q && WS_GQ - WS_V == WS_K - WS_Q && WS_GI - WS_GQ == WS_K - WS_Q && WS_GG - WS_GI == WS_K - WS_Q, "group outputs equally spaced");
          E.G = (float*)(ws + WS_G); E.lbl = F.in[5]; E.qscale = attn_body::C2;
          pg8::gemm_phase<pg8::EpiIn, pg8::StaticOrder, PG8_ALIGN, PG8_SP2>(F.lds + RING_OFF, g, S, E); }
        { pg8::Gemm g{(const pg8::bf16_t*)(ws + WS_MEMN), (const pg8::bf16_t*)(ws + WS_WXKV), D, D}; pg8::StaticOrder S; S.init(MMEM, 2 * D, F.G, (cb >= 128 && cb < 160) ? cb - 128 : -1);
          pg8::EpiBf16 E{(pg8::bf16_t*)(ws + WS_KMEM), D, D, (size_t)(WS_VMEM - WS_KMEM) / 2, 1.0f};
          pg8::gemm_phase<pg8::EpiBf16, pg8::StaticOrder, PG8_ALIGN, PG8_SP2>(F.lds + RING_OFF, g, S, E); }
        if (BOTH(1)) GRID_BAR();
    }

    if (IN(2)) {
        { const attn_body::AttnTensors AT{(const attn_body::bf16*)(ws + WS_Q), (const attn_body::bf16*)(ws + WS_K), (const attn_body::bf16*)(ws + WS_V), (attn_body::bf16*)(ws + WS_AO), (const float*)(ws + WS_FCUM)};
          const attn_body::StaticOrder S((int)F.G, (int)blockIdx.x);
          attn_body::attn_phase<attn_body::StaticOrder>((char*)lds + RING_OFF, AT, S); }
        __syncthreads();
        hg_local_states(F);
        { const bool wk = cb < 64; pg8::Gemm g{(const pg8::bf16_t*)(ws + (wk ? WS_KMEM : WS_WXO)), (const pg8::bf16_t*)(ws + (wk ? WS_WQ : WS_VMEM)), 256, D};
          pg8::SmallOrder S{wk ? 0 : 1, cb < 128 ? (cb & 63) : -1};
          pg8::EpiBf16 E{(pg8::bf16_t*)(ws + (wk ? WS_WKT : WS_VWT)), D, 0, 0, wk ? 0.0625f * LOG2E : 1.0f};
          pg8::gemm_phase<pg8::EpiBf16, pg8::SmallOrder, PG8_ALIGN, PG8_SP2>(F.lds + RING_OFF, g, S, E); }
        if (BOTH(2)) GRID_BAR();
    }
    if (IN(3)) { hg_scan(F); if (BOTH(3)) GRID_BAR(); }
    if (IN(4)) { hg_outputs(F); if (BOTH(4)) GRID_BAR(); }
    if (IN(5)) {
        pg8::Gemm g{(const pg8::bf16_t*)AO, (const pg8::bf16_t*)(ws + WS_WOUT), D, D}; pg8::StaticOrder S; S.init(M, D, F.G, cb);
        pg8::EpiRes E{F.in[0], F.out, (pg8::bf16_t*)XB, SS};
        pg8::gemm_phase<pg8::EpiRes, pg8::StaticOrder, PG8_ALIGN, PG8_SP2>(F.lds + RING_OFF, g, S, E);
        if (BOTH(5)) GRID_BAR();
    }
    if (IN(6)) {
        pg8::Gemm g{(const pg8::bf16_t*)XB, (const pg8::bf16_t*)(ws + WS_WKT), D, D}; pg8::StaticOrder S; S.init(M, D, F.G, cb, SEQ / 256, (size_t)D * D * 2);
        pg8::EpiSoftmax E{(pg8::bf16_t*)AO, SS};
        if (F.G == 256) pg8::gemm_phase<pg8::EpiSoftmax, pg8::StaticOrder, false, PG8_SP2>(F.lds + RING_OFF, g, S, E);
        if (BOTH(6)) GRID_BAR();
    }
    if (IN(7)) {
        pg8::Gemm g{(const pg8::bf16_t*)AO, (const pg8::bf16_t*)(ws + WS_VWT), D, D}; pg8::StaticOrder S; S.init(M, D, F.G, cb, SEQ / 256, (size_t)D * D * 2);
        pg8::EpiRes E{F.out, F.out, (pg8::bf16_t*)XB, SS};
        pg8::gemm_phase<pg8::EpiRes, pg8::StaticOrder, PG8_ALIGN, PG8_SP2>(F.lds + RING_OFF, g, S, E);
        if (BOTH(7)) GRID_BAR();
    }
    if (IN(8)) {
        pg8::Gemm g{(const pg8::bf16_t*)XB, (const pg8::bf16_t*)(ws + WS_W1), D, D}; pg8::StaticOrder S; S.init(M, FF, F.G, cb);
        pg8::EpiRelu2 E{(pg8::bf16_t*)(ws + WS_H), SS};
        pg8::gemm_phase<pg8::EpiRelu2, pg8::StaticOrder, PG8_ALIGN, PG8_SP2>(F.lds + RING_OFF, g, S, E);
        if (BOTH(8)) GRID_BAR();
    }
    if (IN(9)) {
        pg8::Gemm g{(const pg8::bf16_t*)(ws + WS_H), (const pg8::bf16_t*)(ws + WS_W2), FF, FF}; pg8::StaticOrder S; S.init(M, D, F.G, cb);
        pg8::EpiRes E{F.out, F.out, nullptr, SS};
        pg8::gemm_phase<pg8::EpiRes, pg8::StaticOrder, PG8_ALIGN, PG8_SP2>(F.lds + RING_OFF, g, S, E);
        if (BOTH(9)) GRID_BAR();
    }
    if (IN(10)) {
        const int gw = F.vcu * NWAVES + F.wave, NGW = F.G * NWAVES; const GAS f32x4* gr = (const GAS f32x4*)F.in[16] + F.lane;
        for (int m = gw; m < M; m += NGW) {
            GAS f32x4* xr = (GAS f32x4*)(F.out + (size_t)m * D) + F.lane; f32x4 v[4]; float s = 0.f;
#pragma unroll
            for (int j = 0; j < 4; ++j) { v[j] = xr[64 * j]; s += (v[j].x * v[j].x + v[j].y * v[j].y) + (v[j].z * v[j].z + v[j].w * v[j].w); }
            const float rstd = 1.0f / sqrtf(wave_sum(s) * (1.f / D) + EPS);
#pragma unroll
            for (int j = 0; j < 4; ++j) xr[64 * j] = v[j] * rstd * gr[64 * j];
        }
    }
#undef IN
#undef BOTH
}

extern "C" void kernel_launch(void* const* d_in, const int* in_sizes, int n_in, void* d_out, int out_size, void* d_ws, size_t ws_size, hipStream_t stream) {
    static int grid = 0;
    if (grid == 0) {
        if (n_in != 17 || in_sizes[0] != M * D || out_size != M * D || ws_size < WS_END) { fprintf(stderr, "kernel_launch: unexpected problem (n_in %d, in0 %d, out %d, ws %zu); nothing launched\n", n_in, n_in > 0 ? in_sizes[0] : -1, out_size, ws_size); grid = -1; return; }
        int dev = 0, cus = 0, per_cu = 0;
        if (hipGetDevice(&dev) != hipSuccess || hipDeviceGetAttribute(&cus, hipDeviceAttributeMultiprocessorCount, dev) != hipSuccess) { fprintf(stderr, "kernel_launch: device query failed\n"); grid = -1; return; }
        if (hipFuncSetAttribute((const void*)fwd_mega, hipFuncAttributeMaxDynamicSharedMemorySize, LDS_BYTES) != hipSuccess) { fprintf(stderr, "kernel_launch: hipFuncSetAttribute failed\n"); grid = -1; return; }
        if (hipOccupancyMaxActiveBlocksPerMultiprocessor(&per_cu, (const void*)fwd_mega, NWAVES * 64, LDS_BYTES) != hipSuccess || per_cu < 1)
            fprintf(stderr, "kernel_launch: note: occupancy query reports %d workgroups per CU\n", per_cu);
        (void)hipGetLastError();
        grid = cus;
        if (grid != 256) fprintf(stderr, "kernel_launch: %d CUs; this kernel is built for 256\n", grid);
    }
    if (grid < 0) return;
    if (hipMemsetAsync((char*)d_ws + WS_CTL, 0, CTL_ZERO_BYTES, stream) != hipSuccess) { fprintf(stderr, "kernel_launch: memset failed\n"); return; }
    Args a{};
    for (int i = 0; i < 17; ++i) a.in[i] = (const float*)d_in[i];
    a.out = (float*)d_out; a.ws = (unsigned char*)d_ws;
    for (int li = 0; li < N_LAUNCHES; ++li) {
        a.ph_lo = (N_LAUNCHES == 1) ? 0 : li; a.ph_hi = (N_LAUNCHES == 1) ? N_PHASES : li + 1; a.li = li;
        hipLaunchKernelGGL(fwd_mega, dim3(grid), dim3(NWAVES * 64), LDS_BYTES, stream, a);
        const hipError_t le = hipPeekAtLastError();
        if (le != hipSuccess) { fprintf(stderr, "kernel_launch: launch %d failed: %s\n", li, hipGetErrorName(le)); break; }
    }
}
```

```cpp
#include <hip/hip_runtime.h>
#include <hip/hip_bf16.h>
#include <cstdio>
#include <cstdint>
#include <cmath>
namespace pg8 {
#define PG8_LAS __attribute__((address_space(3)))
typedef unsigned short bf16_t;
typedef short bf16x8 __attribute__((ext_vector_type(8)));
typedef float f32x4 __attribute__((ext_vector_type(4)));
typedef unsigned u32x4 __attribute__((ext_vector_type(4)));
constexpr int BM = 256, BK = 64, HALF = 128, HTB = HALF * BK * 2  , STAGE_BYTES = 8 * HTB, NXCD = 8, WGM = 8;

__host__ __device__ __forceinline__ int lds_byte(int r, int c) { const int st = (r >> 4) * 2 + (c >> 5), rr = r & 15, cc = c & 31, ob = rr * 64 + cc * 2; return st * 1024 + (ob ^ (((ob >> 9) & 1) << 5)); }
__host__ __device__ __forceinline__ void stage_rc(int b, int& R, int& C) { const int st = b / 1024, sb = b % 1024, swz = sb ^ (((sb >> 9) & 1) << 5); R = (st >> 1) * 16 + swz / 64; C = (st & 1) * 32 + (swz % 64) / 2; }
__host__ __device__ __forceinline__ int perm32(int rho) { const int n = rho >> 4, i = rho & 15; return 8 * (i >> 2) + 4 * n + (i & 3); }

struct Unit { int pm, pn; };
struct Gemm { const bf16_t* A; const bf16_t* Bt; int K; int ld; };

struct StaticOrder {
    int nM, nN, nwg, G, c, pmb; size_t bstride;
    __host__ __device__ void init(int M, int N, int G_, int c_, int pmb_ = 0, size_t bstride_ = 0) { nM = M / BM; nN = N / BM; nwg = nM * nN; G = G_; c = c_; pmb = pmb_; bstride = bstride_; }
    __host__ __device__ bool next(int i, Unit& u) const {
        if (c < 0) return false;
        const long L = (long)i * G + c; if (L >= nwg) return false;
        int wgid = (int)L; { const int q = nwg / NXCD, r = nwg % NXCD, xcd = wgid % NXCD, off = wgid / NXCD; wgid = (xcd < r ? xcd * (q + 1) : r * (q + 1) + (xcd - r) * q) + off; }
        const int nig = WGM * nN, gid = wgid / nig, fm = gid * WGM, gsz = (nM - fm) < WGM ? (nM - fm) : WGM;
        u.pm = fm + ((wgid % nig) % gsz); u.pn = (wgid % nig) / gsz; return true;
    }
    __device__ __forceinline__ size_t a_off(const Unit& u, size_t tstep) const { return (size_t)u.pm * tstep; }
    __device__ __forceinline__ size_t b_off(const Unit& u, size_t tstep) const { return (size_t)u.pn * tstep + (pmb ? (size_t)(u.pm / pmb) * bstride : (size_t)0); }
    __device__ __forceinline__ void a_ready(const Unit&) const {}
    __device__ __forceinline__ void done(const Unit&) const {}
};
struct SmallOrder {
    int mode, L;
    __device__ __forceinline__ bool next(int i, Unit& u) const { if (i != 0 || L < 0 || L >= 64) return false; u.pm = L >> 2; u.pn = L & 3; return true; }
    __device__ __forceinline__ size_t a_off(const Unit& u, size_t tstep) const { return mode == 0 ? (size_t)(u.pm >> 2) * tstep + (size_t)(u.pm & 3) * 512 : (size_t)(u.pm & 3) * tstep + (size_t)u.pn * 512; }
    __device__ __forceinline__ size_t b_off(const Unit& u, size_t tstep) const { return mode == 0 ? (size_t)u.pn * tstep + (size_t)(u.pm & 3) * 512 : (size_t)(u.pm >> 2) * tstep + (size_t)u.pn * 512; }
    __device__ __forceinline__ void a_ready(const Unit&) const {}
    __device__ __forceinline__ void done(const Unit&) const {}
};

__device__ __forceinline__ unsigned cvt_pk_bf16(float lo, float hi) { unsigned r; asm volatile("v_cvt_pk_bf16_f32 %0, %1, %2" : "=v"(r) : "v"(lo), "v"(hi)); return r; }
__device__ __forceinline__ u32x4 pack8(const f32x4 v0, const f32x4 v1) { u32x4 w; w.x = cvt_pk_bf16(v0[0], v0[1]); w.y = cvt_pk_bf16(v0[2], v0[3]); w.z = cvt_pk_bf16(v1[0], v1[1]); w.w = cvt_pk_bf16(v1[2], v1[3]); return w; }
__device__ __forceinline__ float silu_f(float x) { return x * __builtin_amdgcn_rcpf(1.0f + __expf(-x)); }
__device__ __forceinline__ float row_rstd(const float* ss, int row) {
    const f32x4* p = (const f32x4*)(ss + (size_t)row * 16); const f32x4 a = p[0], b = p[1], c = p[2], d = p[3];
    const float s = ((a[0] + a[1]) + (a[2] + a[3])) + ((b[0] + b[1]) + (b[2] + b[3])) + ((c[0] + c[1]) + (c[2] + c[3])) + ((d[0] + d[1]) + (d[2] + d[3]));
    return 1.0f / sqrtf(s * (1.0f / 1024.0f) + 1e-6f);
}

struct EpiBf16 {
    static constexpr bool PERM = true, AFTER_DRAIN = false;
    bf16_t* O; int ldc; int split_cols; size_t split_stride; float scale;
    __device__ __forceinline__ void operator()(const f32x4 (&acc)[2][2][4][2], const Unit& u, int wr, int wc, int fr, int fq) const {
        const int row0 = u.pm * BM + wr * 64 + fr; int colt = u.pn * BM; bf16_t* base = O;
        if (split_cols) { const int t = colt / split_cols; base += (size_t)t * split_stride; colt -= t * split_cols; }
        const int col0 = colt + wc * 32 + 8 * fq;
#pragma unroll
        for (int ai = 0; ai < 2; ++ai)
#pragma unroll
            for (int m = 0; m < 4; ++m) { bf16_t* rowp = base + (size_t)(row0 + ai * HALF + m * 16) * ldc + col0;
#pragma unroll
                for (int bj = 0; bj < 2; ++bj) *(u32x4*)(rowp + bj * HALF) = pack8(acc[ai][bj][m][0] * scale, acc[ai][bj][m][1] * scale); }
    }
};

struct EpiIn {
    static constexpr bool PERM = true, AFTER_DRAIN = false;
    unsigned* amax;
    bf16_t* Ob; size_t ostride; float* G; const float* lbl; float qscale;
    __device__ __forceinline__ void operator()(const f32x4 (&acc)[2][2][4][2], const Unit& u, int wr, int wc, int fr, int fq) const {
        const int grp = u.pn >> 1, row0 = u.pm * BM + wr * 64 + fr, col0 = (u.pn & 1) * BM + wc * 32 + 8 * fq;
        if (grp == 4) {
            float lb[2][8];
#pragma unroll
            for (int bj = 0; bj < 2; ++bj)
#pragma unroll
                for (int e = 0; e < 8; ++e) { const int c = col0 + bj * HALF + e; lb[bj][e] = 1.0f / (1.0f + expf(lbl[512 + c] - lbl[c])); }
#pragma unroll
            for (int ai = 0; ai < 2; ++ai)
#pragma unroll
                for (int m = 0; m < 4; ++m) { float* rowp = G + (size_t)(row0 + ai * HALF + m * 16) * 512 + col0;
#pragma unroll
                    for (int bj = 0; bj < 2; ++bj) { f32x4 o[2];
#pragma unroll
                        for (int n = 0; n < 2; ++n)
#pragma unroll
                            for (int e = 0; e < 4; ++e) { const float x = acc[ai][bj][m][n][e], sg = 1.0f / (1.0f + expf(-x)), l = lb[bj][n * 4 + e]; o[n][e] = logf(l + (1.0f - l) * sg); }
                        *(f32x4*)(rowp + bj * HALF) = o[0]; *(f32x4*)(rowp + bj * HALF + 4) = o[1]; } }
            return;
        }
        bf16_t* base = Ob + (size_t)(grp < 4 ? grp : grp - 1) * ostride; const bool act = (grp == 3 || grp == 6); const float sc = (grp == 0) ? qscale : 1.0f;
        float pm[2] = {0.f, 0.f};
#pragma unroll
        for (int ai = 0; ai < 2; ++ai)
#pragma unroll
            for (int m = 0; m < 4; ++m) { bf16_t* rowp = base + (size_t)(row0 + ai * HALF + m * 16) * 512 + col0;
#pragma unroll
                for (int bj = 0; bj < 2; ++bj) { f32x4 v0 = acc[ai][bj][m][0], v1 = acc[ai][bj][m][1];
                    if (act) {
#pragma unroll
                        for (int e = 0; e < 4; ++e) { v0[e] = silu_f(v0[e]); v1[e] = silu_f(v1[e]); } }
                    v0 = v0 * sc; v1 = v1 * sc;
                    *(u32x4*)(rowp + bj * HALF) = pack8(v0, v1);
                    if (grp <= 1) { float p = ((v0[0] * v0[0] + v0[1] * v0[1]) + (v0[2] * v0[2] + v0[3] * v0[3])) + ((v1[0] * v1[0] + v1[1] * v1[1]) + (v1[2] * v1[2] + v1[3] * v1[3]));
                        p += __shfl_xor(p, 16); p += __shfl_xor(p, 32); pm[bj] = fmaxf(pm[bj], p); } } }
        if (grp <= 1) {
#pragma unroll
            for (int bj = 0; bj < 2; ++bj) { float x = pm[bj]; x = fmaxf(x, __shfl_xor(x, 1)); x = fmaxf(x, __shfl_xor(x, 2)); x = fmaxf(x, __shfl_xor(x, 4)); x = fmaxf(x, __shfl_xor(x, 8));
                if (fr == 0 && fq == 0) __hip_atomic_fetch_max(amax + grp * 32 + (u.pm >> 4) * 8 + (u.pn & 1) * 4 + 2 * bj + (wc >> 1), __float_as_uint(x), __ATOMIC_RELAXED, __HIP_MEMORY_SCOPE_AGENT); } }
    }
};

struct EpiRes {
    static constexpr bool PERM = true, AFTER_DRAIN = false;
    const float* base; float* out; bf16_t* xb; float* ss;
    __device__ __forceinline__ void operator()(const f32x4 (&acc)[2][2][4][2], const Unit& u, int wr, int wc, int fr, int fq) const {
        const int row0 = u.pm * BM + wr * 64 + fr, col0 = u.pn * BM + wc * 32 + 8 * fq;
#pragma unroll
        for (int ai = 0; ai < 2; ++ai)
#pragma unroll
            for (int m = 0; m < 4; ++m) { const int row = row0 + ai * HALF + m * 16; const size_t off = (size_t)row * 1024 + col0; float q = 0.f;
#pragma unroll
                for (int bj = 0; bj < 2; ++bj) { const f32x4 b0 = *(const f32x4*)(base + off + bj * HALF), b1 = *(const f32x4*)(base + off + bj * HALF + 4);
                    const f32x4 v0 = acc[ai][bj][m][0] + b0, v1 = acc[ai][bj][m][1] + b1;
                    *(f32x4*)(out + off + bj * HALF) = v0; *(f32x4*)(out + off + bj * HALF + 4) = v1;
                    if (xb) *(u32x4*)(xb + off + bj * HALF) = pack8(v0, v1);
                    q += ((v0[0] * v0[0] + v0[1] * v0[1]) + (v0[2] * v0[2] + v0[3] * v0[3])) + ((v1[0] * v1[0] + v1[1] * v1[1]) + (v1[2] * v1[2] + v1[3] * v1[3])); }
                q += __shfl_xor(q, 16); q += __shfl_xor(q, 32);
                if (fq == 0) ss[(size_t)row * 16 + u.pn * 4 + wc] = q; }
    }
};

struct EpiRelu2 {
    static constexpr bool PERM = true, AFTER_DRAIN = false;
    bf16_t* O; const float* ss;
    __device__ __forceinline__ void operator()(const f32x4 (&acc)[2][2][4][2], const Unit& u, int wr, int wc, int fr, int fq) const {
        const int row0 = u.pm * BM + wr * 64 + fr, col0 = u.pn * BM + wc * 32 + 8 * fq;
#pragma unroll
        for (int ai = 0; ai < 2; ++ai)
#pragma unroll
            for (int m = 0; m < 4; ++m) { const int row = row0 + ai * HALF + m * 16; const float rs = row_rstd(ss, row); bf16_t* rowp = O + (size_t)row * 4096 + col0;
#pragma unroll
                for (int bj = 0; bj < 2; ++bj) { f32x4 v0 = acc[ai][bj][m][0] * rs, v1 = acc[ai][bj][m][1] * rs;
#pragma unroll
                    for (int e = 0; e < 4; ++e) { const float a = fmaxf(v0[e], 0.f), b = fmaxf(v1[e], 0.f); v0[e] = a * a; v1[e] = b * b; }
                    *(u32x4*)(rowp + bj * HALF) = pack8(v0, v1); } }
    }
};

struct EpiSoftmax {
    static constexpr bool PERM = true, AFTER_DRAIN = true;
    bf16_t* O; const float* ss;
    __device__ __forceinline__ void fused(f32x4 (&acc)[2][2][4][2], const Unit& u, int wr, int wc, int fr, int fq, PG8_LAS unsigned char* lds, int wid, int lane) const {
        typedef float f32x2v __attribute__((ext_vector_type(2)));
        PG8_LAS f32x2v* P = (PG8_LAS f32x2v*)lds;
        const int row0 = u.pm * BM + wr * 64 + fr, col0 = u.pn * BM + wc * 32 + 8 * fq;
        float mw[2][4];
#pragma unroll
        for (int ai = 0; ai < 2; ++ai)
#pragma unroll
            for (int m = 0; m < 4; ++m) { const float rs = row_rstd(ss, row0 + ai * HALF + m * 16); float mx = -INFINITY;
#pragma unroll
                for (int bj = 0; bj < 2; ++bj)
#pragma unroll
                    for (int n = 0; n < 2; ++n) { acc[ai][bj][m][n] = acc[ai][bj][m][n] * rs; const f32x4 x = acc[ai][bj][m][n]; mx = fmaxf(mx, fmaxf(fmaxf(x[0], x[1]), fmaxf(x[2], x[3]))); }
                mx = fmaxf(mx, __shfl_xor(mx, 16)); mx = fmaxf(mx, __shfl_xor(mx, 32)); float s = 0.f;
#pragma unroll
                for (int bj = 0; bj < 2; ++bj)
#pragma unroll
                    for (int n = 0; n < 2; ++n) { f32x4 x = acc[ai][bj][m][n];
#pragma unroll
                        for (int e = 0; e < 4; ++e) { x[e] = __builtin_amdgcn_exp2f(x[e] - mx); s += x[e]; }
                        acc[ai][bj][m][n] = x; }
                s += __shfl_xor(s, 16); s += __shfl_xor(s, 32);
                mw[ai][m] = mx;
                if (fq == 0) P[(ai * HALF + wr * 64 + m * 16 + fr) * 4 + wc] = (f32x2v){mx, s}; }
        asm volatile("s_waitcnt lgkmcnt(0)" ::: "memory"); __builtin_amdgcn_s_barrier(); asm volatile("" ::: "memory");
#pragma unroll
        for (int ai = 0; ai < 2; ++ai)
#pragma unroll
            for (int m = 0; m < 4; ++m) { const int r = ai * HALF + wr * 64 + m * 16 + fr;
                const f32x2v a = P[r * 4 + 0], b = P[r * 4 + 1], c = P[r * 4 + 2], d = P[r * 4 + 3];
                const float M = fmaxf(fmaxf(a.x, b.x), fmaxf(c.x, d.x));
                const float tot = (a.y * __builtin_amdgcn_exp2f(a.x - M) + b.y * __builtin_amdgcn_exp2f(b.x - M)) + (c.y * __builtin_amdgcn_exp2f(c.x - M) + d.y * __builtin_amdgcn_exp2f(d.x - M));
                const float f = __builtin_amdgcn_exp2f(mw[ai][m] - M) / tot;
                bf16_t* rowp = O + (size_t)(row0 + ai * HALF + m * 16) * 1024 + col0;
#pragma unroll
                for (int bj = 0; bj < 2; ++bj) *(u32x4*)(rowp + bj * HALF) = pack8(acc[ai][bj][m][0] * f, acc[ai][bj][m][1] * f); }
        asm volatile("s_waitcnt lgkmcnt(0)" ::: "memory"); __builtin_amdgcn_s_barrier(); asm volatile("" ::: "memory");
    }
};

template <class Epi, class Sched, bool ALIGN_EPI = false, bool SP2 = false>
__device__ __forceinline__ void gemm_phase(PG8_LAS unsigned char* lds, const Gemm g, const Sched& S, const Epi& E) {
    const int tid = threadIdx.x, wid = __builtin_amdgcn_readfirstlane(tid >> 6), lane = tid & 63, wr = wid >> 2, wc = wid & 3, fr = lane & 15, fq = lane >> 4;
    const int K = g.K, nt = K / BK, LD = g.ld;
    unsigned voffA[2], voffB[2];
#pragma unroll
    for (int i = 0; i < 2; ++i) { int R, C; stage_rc(tid * 16 + i * 8192, R, C); const int Rb = Epi::PERM ? ((R & ~31) + perm32(R & 31)) : R;
        voffA[i] = (unsigned)(R * LD + C) * 2u; voffB[i] = (unsigned)(Rb * LD + C) * 2u; }
    const size_t kstep = (size_t)(BK * 2);
    const size_t hstep = (size_t)HALF * LD * 2;
    const size_t tstep = 2 * hstep;
    const unsigned ldsw = (unsigned)wid * 1024u;
    const int aoff = lds_byte(wr * 64 + fr, fq * 8), boff = lds_byte(wc * 32 + fr, fq * 8);
#define PG8_SA(b, h) (((b) * 2 + (h)) * HTB)
#define PG8_SB(b, h) ((4 + (b) * 2 + (h)) * HTB)
#define PG8_STAGE(bufoff, gbase, voff) do { _Pragma("unroll") for (int _i = 0; _i < 2; ++_i) \
        __builtin_amdgcn_global_load_lds((const unsigned*)((const char*)(gbase) + (voff)[_i]), (PG8_LAS unsigned*)(lds + (bufoff) + ldsw + _i * 8192), 16, 0, 0); } while (0)
#define PG8_LDA(dst, b, h) do { _Pragma("unroll") for (int m = 0; m < 4; ++m) _Pragma("unroll") for (int k = 0; k < 2; ++k) dst[m][k] = *(const PG8_LAS bf16x8*)(lds + PG8_SA(b, h) + aoff + m * 2048 + k * 1024); } while (0)
#define PG8_LDB(dst, b, h) do { _Pragma("unroll") for (int n = 0; n < 2; ++n) _Pragma("unroll") for (int k = 0; k < 2; ++k) dst[n][k] = *(const PG8_LAS bf16x8*)(lds + PG8_SB(b, h) + boff + n * 2048 + k * 1024); } while (0)
#define PG8_MMA(ai, bj, At, Bt) do { __builtin_amdgcn_s_setprio(1); _Pragma("unroll") for (int m = 0; m < 4; ++m) _Pragma("unroll") for (int n = 0; n < 2; ++n) _Pragma("unroll") for (int k = 0; k < 2; ++k) \
        acc[ai][bj][m][n] = __builtin_amdgcn_mfma_f32_16x16x32_bf16(Bt[n][k], At[m][k], acc[ai][bj][m][n], 0, 0, 0); __builtin_amdgcn_s_setprio(0); } while (0)
#define PG8_WAIT_V(n) asm volatile("s_waitcnt vmcnt(" #n ")" ::: "memory")
#define PG8_WAIT_L(n) asm volatile("s_waitcnt lgkmcnt(" #n ")" ::: "memory")
#define PG8_BAR __builtin_amdgcn_s_barrier()
#define PG8_SCHED __builtin_amdgcn_sched_barrier(0)
    Unit cur, nxt; int ui = 0;
    if (!S.next(0, cur)) return;
    f32x4 acc[2][2][4][2];
#pragma unroll
    for (int a = 0; a < 2; ++a)
#pragma unroll
        for (int b = 0; b < 2; ++b)
#pragma unroll
            for (int m = 0; m < 4; ++m)
#pragma unroll
                for (int n = 0; n < 2; ++n) acc[a][b][m][n] = (f32x4){0.f, 0.f, 0.f, 0.f};
    bf16x8 At[4][2], B0[2][2], B1[2][2];
    const char* cA = (const char*)g.A + S.a_off(cur, tstep); const char* cB = (const char*)g.Bt + S.b_off(cur, tstep);
    S.a_ready(cur);
    if constexpr (SP2) {
        PG8_STAGE(PG8_SB(0, 0), cB, voffB); PG8_STAGE(PG8_SB(0, 1), cB + hstep, voffB); PG8_STAGE(PG8_SA(0, 0), cA, voffA); PG8_STAGE(PG8_SA(0, 1), cA + hstep, voffA);
        if (wr == 1) PG8_BAR;
        PG8_WAIT_V(2); PG8_BAR;
        PG8_STAGE(PG8_SB(1, 0), cB + kstep, voffB); PG8_STAGE(PG8_SA(1, 0), cA + kstep, voffA); PG8_STAGE(PG8_SB(1, 1), cB + hstep + kstep, voffB);
        PG8_WAIT_V(6); PG8_BAR;
    } else {
        PG8_STAGE(PG8_SB(0, 0), cB, voffB); PG8_STAGE(PG8_SA(0, 0), cA, voffA); PG8_STAGE(PG8_SB(0, 1), cB + hstep, voffB); PG8_STAGE(PG8_SA(0, 1), cA + hstep, voffA);
        if (wr == 1) PG8_BAR;
        PG8_WAIT_V(4); PG8_BAR;
        PG8_STAGE(PG8_SB(1, 0), cB + kstep, voffB); PG8_STAGE(PG8_SA(1, 0), cA + kstep, voffA); PG8_STAGE(PG8_SB(1, 1), cB + hstep + kstep, voffB);
        PG8_WAIT_V(6); PG8_BAR;
    }
    for (;;) {
        const bool has_next = S.next(ui + 1, nxt);
        const char* nA = has_next ? (const char*)g.A + S.a_off(nxt, tstep) : cA; const char* nB = has_next ? (const char*)g.Bt + S.b_off(nxt, tstep) : cB;
        for (int t = 0; t < nt; t += 2) {
            const bool last = (t == nt - 2);
            const char* a1 = cA + (size_t)(t + 1) * kstep;
            const char* a2 = last ? nA : cA + (size_t)(t + 2) * kstep; const char* b2 = last ? nB : cB + (size_t)(t + 2) * kstep;
            const char* a3 = a2 + kstep; const char* b3 = b2 + kstep;
            if (last && has_next) S.a_ready(nxt);
            if constexpr (SP2) {
            PG8_LDB(B0, 0, 0); PG8_LDB(B1, 0, 1); PG8_SCHED; PG8_LDA(At, 0, 0); PG8_STAGE(PG8_SA(1, 1), a1 + hstep, voffA);
            PG8_WAIT_V(8); PG8_WAIT_L(0); PG8_BAR; PG8_MMA(0, 0, At, B0); PG8_MMA(0, 1, At, B1); PG8_BAR; PG8_SCHED;
            PG8_LDA(At, 0, 1); PG8_STAGE(PG8_SB(0, 0), b2, voffB); PG8_STAGE(PG8_SB(0, 1), b2 + hstep, voffB); PG8_STAGE(PG8_SA(0, 0), a2, voffA);
            PG8_WAIT_V(8); PG8_WAIT_L(0); PG8_BAR; PG8_MMA(1, 0, At, B0); PG8_MMA(1, 1, At, B1); PG8_BAR; PG8_SCHED;
            PG8_LDB(B0, 1, 0); PG8_LDB(B1, 1, 1); PG8_SCHED; PG8_LDA(At, 1, 0); PG8_STAGE(PG8_SA(0, 1), a2 + hstep, voffA);
            PG8_WAIT_V(8); PG8_WAIT_L(0); PG8_BAR; PG8_MMA(0, 0, At, B0); PG8_MMA(0, 1, At, B1); PG8_BAR; PG8_SCHED;
            PG8_LDA(At, 1, 1); PG8_STAGE(PG8_SB(1, 0), b3, voffB); PG8_STAGE(PG8_SB(1, 1), b3 + hstep, voffB); PG8_STAGE(PG8_SA(1, 0), a3, voffA);
            PG8_WAIT_V(8); PG8_WAIT_L(0); PG8_BAR; PG8_MMA(1, 0, At, B0); PG8_MMA(1, 1, At, B1); PG8_BAR; PG8_SCHED;
            } else {
            PG8_LDB(B0, 0, 0); PG8_SCHED; PG8_LDA(At, 0, 0); PG8_STAGE(PG8_SA(1, 1), a1 + hstep, voffA);
            PG8_WAIT_L(8); PG8_BAR; PG8_WAIT_L(0); PG8_MMA(0, 0, At, B0); PG8_BAR; PG8_SCHED;
            PG8_LDB(B1, 0, 1); PG8_STAGE(PG8_SB(0, 0), b2, voffB);
            PG8_BAR; PG8_WAIT_L(0); PG8_MMA(0, 1, At, B1); PG8_BAR;
            PG8_LDA(At, 0, 1); PG8_STAGE(PG8_SA(0, 0), a2, voffA);
            PG8_BAR; PG8_WAIT_L(0); PG8_MMA(1, 0, At, B0); PG8_BAR; PG8_SCHED;
            PG8_STAGE(PG8_SB(0, 1), b2 + hstep, voffB);
            PG8_WAIT_V(6); PG8_BAR; PG8_MMA(1, 1, At, B1); PG8_BAR;
            PG8_LDB(B0, 1, 0); PG8_SCHED; PG8_LDA(At, 1, 0); PG8_STAGE(PG8_SA(0, 1), a2 + hstep, voffA);
            PG8_WAIT_L(8); PG8_BAR; PG8_WAIT_L(0); PG8_MMA(0, 0, At, B0); PG8_BAR; PG8_SCHED;
            PG8_LDB(B1, 1, 1); PG8_STAGE(PG8_SB(1, 0), b3, voffB);
            PG8_BAR; PG8_WAIT_L(0); PG8_MMA(0, 1, At, B1); PG8_BAR;
            PG8_LDA(At, 1, 1); PG8_STAGE(PG8_SA(1, 0), a3, voffA);
            PG8_BAR; PG8_WAIT_L(0); PG8_MMA(1, 0, At, B0); PG8_BAR; PG8_SCHED;
            PG8_STAGE(PG8_SB(1, 1), b3 + hstep, voffB);
            PG8_WAIT_V(6); PG8_BAR; PG8_MMA(1, 1, At, B1); PG8_BAR;
            }
        }
        if constexpr (ALIGN_EPI) { if (wr == 0) PG8_BAR; }
        if constexpr (!Epi::AFTER_DRAIN) { E(acc, cur, wr, wc, fr, fq); S.done(cur); }
        if (!has_next) break;
#pragma unroll
        for (int a = 0; a < 2; ++a)
#pragma unroll
            for (int b = 0; b < 2; ++b)
#pragma unroll
                for (int m = 0; m < 4; ++m)
#pragma unroll
                    for (int n = 0; n < 2; ++n) acc[a][b][m][n] = (f32x4){0.f, 0.f, 0.f, 0.f};
        cur = nxt; cA = nA; cB = nB; ++ui;
        if constexpr (ALIGN_EPI) { if (wr == 1) PG8_BAR; }
    }
    PG8_WAIT_V(0);
    if constexpr (!ALIGN_EPI) { if (wr == 0) PG8_BAR; }
    PG8_BAR;
    if constexpr (Epi::AFTER_DRAIN) { E.fused(acc, cur, wr, wc, fr, fq, lds, wid, lane); S.done(cur); }
#undef PG8_SA
#undef PG8_SB
#undef PG8_STAGE
#undef PG8_LDA
#undef PG8_LDB
#undef PG8_MMA
#undef PG8_WAIT_V
#undef PG8_WAIT_L
#undef PG8_BAR
#undef PG8_SCHED
}
}

#ifndef PG8_SP2
#define PG8_SP2 true
#endif
#ifndef PG8_ALIGN
#define PG8_ALIGN true
#endif
namespace attn_body {
using bf16=__hip_bfloat16;
using bf16x8=__attribute__((ext_vector_type(8)))short;
using s16x4=__attribute__((ext_vector_type(4)))short;
using f32x16=__attribute__((ext_vector_type(16)))float;
using u32x4=__attribute__((ext_vector_type(4)))unsigned;
using f32x4v=__attribute__((ext_vector_type(4)))float;
constexpr int BATCH=4,NHEAD=8,SEQ=4096,D=64,DM=NHEAD*D,DMO=1024;
constexpr int NW=8,QBLK=32,QB=QBLK*NW,KVBLK=64,NQB=SEQ/QB;
constexpr int ATTN_PITCH=DM, ATTN_UNIT_ROWS=QB;
__device__ __forceinline__ int crow(int r,int hi){return (r&3)+8*(r>>2)+4*hi;}
#define SBAR() __builtin_amdgcn_sched_barrier(0)
__device__ __forceinline__ void cmask(f32x16&p0,f32x16&p1,int jb,int qrel,int hi){
  const float NEG=-INFINITY; int kb=64*jb+4*hi;
  #pragma unroll
  for(int r=0;r<16;++r){int kv=kb+(r&3)+8*(r>>2); if(kv>qrel)p0[r]=NEG; if(kv+32>qrel)p1[r]=NEG;}
}

constexpr int NSLOT=3, SLOTB=8192;
constexpr float PRUNE_THR=40.f;
constexpr int LDS_K=0, LDS_V=NSLOT*SLOTB, LDS_WS=2*NSLOT*SLOTB, LDS_OST=LDS_WS+NW*64*4, LDS_F=LDS_OST+NW*4096, LDS_BYTES=LDS_F+SEQ*4;
constexpr float C2=0.125f*1.4426950408889634f;
__device__ __forceinline__ void glds16(const void*gsrc,unsigned lds_dst){unsigned keep;
  asm volatile("s_mov_b32 %0, m0\n\ts_mov_b32 m0, %2\n\ts_nop 0\n\tglobal_load_lds_dwordx4 %1, off\n\ts_mov_b32 m0, %0":"=&s"(keep):"v"(gsrc),"s"(lds_dst):"memory");}
__device__ __forceinline__ float max3f(float a,float b,float c){float r;asm("v_max3_f32 %0, %1, %2, %3":"=v"(r):"v"(a),"v"(b),"v"(c));return r;}
__device__ __forceinline__ float max2f(float a,float b){float r;asm("v_max_f32_e32 %0, %1, %2":"=v"(r):"v"(a),"v"(b));return r;}
__device__ __forceinline__ float fadd_s(float a,float b){float r;asm("v_add_f32_e32 %0, %1, %2":"=v"(r):"v"(a),"v"(b));return r;}
__device__ __forceinline__ float fsub_s(float a,float b){float r;asm("v_sub_f32_e32 %0, %1, %2":"=v"(r):"v"(a),"v"(b));return r;}
typedef float f32x2_t __attribute__((ext_vector_type(2))); typedef __bf16 bf16x2_t __attribute__((ext_vector_type(2)));
__device__ __forceinline__ unsigned cvtpk_s(float lo,float hi){f32x2_t v={lo,hi};bf16x2_t b=__builtin_convertvector(v,bf16x2_t);return __builtin_bit_cast(unsigned,b);}
#define WAIT_BAR(N) asm volatile("s_waitcnt vmcnt(" #N ") lgkmcnt(0)\n\ts_barrier":::"memory")

__device__ __forceinline__ void qkt(f32x16&p0,f32x16&p1,const char*Kslot,const bf16x8*qr,int r32,int hi){
  const char*kb=Kslot+hi*1024+r32*16;
  #pragma unroll
  for(int d0=0;d0<4;++d0){
    const bf16x8 b0=*reinterpret_cast<const bf16x8*>(kb+d0*2048);
    const bf16x8 b1=*reinterpret_cast<const bf16x8*>(kb+d0*2048+512);
    {p0=__builtin_amdgcn_mfma_f32_32x32x16_bf16(b0,qr[d0],p0,0,0,0);p1=__builtin_amdgcn_mfma_f32_32x32x16_bf16(b1,qr[d0],p1,0,0,0);}}
}
typedef __attribute__((address_space(3))) const char* lds_cptr;
typedef short v4i16_t __attribute__((ext_vector_type(4)));
__device__ __forceinline__ void kload8(bf16x8*kf,lds_cptr kp){
  kf[0]=*(const __attribute__((address_space(3))) bf16x8*)(kp);      kf[1]=*(const __attribute__((address_space(3))) bf16x8*)(kp+512);
  kf[2]=*(const __attribute__((address_space(3))) bf16x8*)(kp+2048); kf[3]=*(const __attribute__((address_space(3))) bf16x8*)(kp+2560);
  kf[4]=*(const __attribute__((address_space(3))) bf16x8*)(kp+4096); kf[5]=*(const __attribute__((address_space(3))) bf16x8*)(kp+4608);
  kf[6]=*(const __attribute__((address_space(3))) bf16x8*)(kp+6144); kf[7]=*(const __attribute__((address_space(3))) bf16x8*)(kp+6656);
}
__device__ __forceinline__ void kload2(bf16x8*kf,lds_cptr kp,int j){ kf[2*j]=*(const __attribute__((address_space(3))) bf16x8*)(kp+j*2048); kf[2*j+1]=*(const __attribute__((address_space(3))) bf16x8*)(kp+j*2048+512); }
__device__ __forceinline__ s16x4 vtr(lds_cptr p){ return __builtin_bit_cast(s16x4,__builtin_amdgcn_ds_read_tr16_b64_v4i16((__attribute__((address_space(3))) v4i16_t*)p)); }
__device__ __forceinline__ float rowmax(const f32x16&p0,const f32x16&p1){
  float a=max3f(p0[0],p0[1],p1[0]),b=max3f(p0[2],p0[3],p1[1]);a=max3f(a,p1[2],p1[3]);
  #pragma unroll
  for(int r=4;r<16;r+=4){a=max3f(a,p0[r],p0[r+1]);b=max3f(b,p0[r+2],p0[r+3]);a=max3f(a,p1[r],p1[r+1]);b=max3f(b,p1[r+2],p1[r+3]);}
  const float m=max2f(a,b);
  auto rr=__builtin_amdgcn_permlane32_swap(__float_as_uint(m),__float_as_uint(m),false,false);
  return max2f(__uint_as_float(rr[0]),__uint_as_float(rr[1]));
}
__device__ __forceinline__ void pv(f32x16*o,int vb,bf16x8 pa0,bf16x8 pa1,bf16x8 pa2,bf16x8 pa3){
  #pragma unroll
  for(int d0=0;d0<2;++d0){s16x4 lo[4],hi[4];
    #pragma unroll
    for(int ks=0;ks<4;++ks){
      asm volatile("ds_read_b64_tr_b16 %0,%1 offset:%c2":"=&v"(lo[ks]):"v"(vb),"i"(d0*4096+ks*1024):"memory");
      asm volatile("ds_read_b64_tr_b16 %0,%1 offset:%c2":"=&v"(hi[ks]):"v"(vb),"i"(d0*4096+ks*1024+512):"memory");}
    asm volatile("s_waitcnt lgkmcnt(0)":::"memory");SBAR();
    #define PK(k) (bf16x8){lo[k][0],lo[k][1],lo[k][2],lo[k][3],hi[k][0],hi[k][1],hi[k][2],hi[k][3]}
    o[d0]=__builtin_amdgcn_mfma_f32_32x32x16_bf16(pa0,PK(0),o[d0],0,0,0);
    o[d0]=__builtin_amdgcn_mfma_f32_32x32x16_bf16(pa1,PK(1),o[d0],0,0,0);
    o[d0]=__builtin_amdgcn_mfma_f32_32x32x16_bf16(pa2,PK(2),o[d0],0,0,0);
    o[d0]=__builtin_amdgcn_mfma_f32_32x32x16_bf16(pa3,PK(3),o[d0],0,0,0);
    #undef PK
  }
}

#ifndef ATTN_STORE16
#define ATTN_STORE16(p,v) (*(u32x4*)(p)=(v))
#endif
template<int THRL> __device__ __forceinline__ void attn_unit(int b,int h,int qb,const bf16*Q,const bf16*__restrict__ K,const bf16*__restrict__ V,bf16*O,const float*__restrict__ Fp,const unsigned*AM,char*shm){
  const int tid=threadIdx.x,lane=tid&63,r32=lane&31,hi=lane>>5; const int wid=__builtin_amdgcn_readfirstlane(tid>>6);
  const long rowbase=(long)b*SEQ; const int q0=qb*QB;
  const bf16*Qw=Q+(rowbase+q0+wid*QBLK)*DM+h*D;
  int t0=0; SBAR();
  { const int bh_=b*NHEAD+h; const float pq_=__uint_as_float(__hip_atomic_load(AM+bh_,__ATOMIC_RELAXED,__HIP_MEMORY_SCOPE_AGENT)),pk_=__uint_as_float(__hip_atomic_load(AM+32+bh_,__ATOMIC_RELAXED,__HIP_MEMORY_SCOPE_AGENT));
    const float Bq=4.08f*sqrtf(pq_*pk_)+PRUNE_THR; const float*Fg_=Fp+(long)bh_*SEQ; const float f0_=Fg_[q0]; const int nt_=(q0+QB)/KVBLK;
    int ln_=lane; asm volatile("":"+v"(ln_));
    bool ok_=(ln_==0); if(ln_>=1&&2*ln_<=nt_-4) ok_=(Bq+f0_-Fg_[128*ln_-1]<=0.f);
    const unsigned long long mk_=__ballot(ok_); t0=__builtin_amdgcn_readfirstlane(2*(63-__clzll(mk_))); }
  SBAR();
  const bf16*Kh=K+(rowbase+(long)t0*KVBLK)*DM+h*D,*Vh=V+(rowbase+(long)t0*KVBLK)*DM+h*D;
  const unsigned lds0=(unsigned)(uintptr_t)shm;
  float*wsf=(float*)(shm+LDS_WS)+wid*64;
  const bf16*ksrc=Kh+(long)lane*DM+wid*8;
  const bf16*vsrc=Vh+(long)(16*(wid&3)+(lane>>2))*DM+(wid>>2)*32+(lane&3)*8;
  const unsigned kdst=lds0+LDS_K+wid*1024, vdst=lds0+LDS_V+wid*1024;
  #define DMA_K(t,slot) glds16(ksrc+(long)(t)*KVBLK*DM,(unsigned)__builtin_amdgcn_readfirstlane(kdst+(slot)))
  #define DMA_V(t,slot) glds16(vsrc+(long)(t)*KVBLK*DM,(unsigned)__builtin_amdgcn_readfirstlane(vdst+(slot)))
  const int vb0=(int)(lds0+LDS_V)+((lane>>4)&1)*32+(lane&3)*8+(4*hi+((lane&15)>>2))*64;
  const char*Kbase=shm+LDS_K; bf16x8 kf[8];
  const lds_cptr shm3=(lds_cptr)shm; const lds_cptr kp0=shm3+LDS_K+hi*1024+r32*16; const lds_cptr vp0=shm3+LDS_V+((lane>>4)&1)*32+(lane&3)*8+(4*hi+((lane&15)>>2))*64;
  const int NT=(q0+QB)/KVBLK-t0;
  { const float*Fg=Fp+((long)b*NHEAD+h)*SEQ; float*Fl=(float*)(shm+LDS_F);
    for(int i=tid*4;i<q0+QB;i+=NW*64*4)*(f32x4v*)(Fl+i)=*(const f32x4v*)(Fg+i); }
  const lds_cptr fl3=shm3+LDS_F+hi*16+t0*256;
  DMA_K(0,0);DMA_V(0,0);DMA_K(1,SLOTB);
  bf16x8 qr[4];
  #pragma unroll
  for(int d0=0;d0<4;++d0)qr[d0]=*reinterpret_cast<const bf16x8*>(&Qw[(long)r32*DM+d0*16+hi*8]);
  float mhat=0.f,l_reg=0.f,aq=0.f,fqv=0.f;f32x16 o[2];o[0]=f32x16{};o[1]=f32x16{};
  const int qrel=wid*QBLK+r32;
  #define CMASK(P0,P1,t) do{int jb_=(t)-(NT-4); if(jb_>=0)cmask(P0,P1,jb_,qrel,hi);}while(0)
  bool resc=false;
  #define START(P0,P1) do{ const float rm=rowmax(P0,P1); resc=false; \
    { const float dl=rm; mhat=fadd_s(mhat,dl); \
      _Pragma("unroll") for(int r=0;r<16;++r){P0[r]=fsub_s(P0[r],dl);P1[r]=fsub_s(P1[r],dl);} \
      aq=fqv-mhat; } \
    _Pragma("unroll") for(int r=0;r<16;++r)P0[r]=__builtin_amdgcn_exp2f(P0[r]); }while(0)
  #define RESC() do{ if(resc){ asm volatile("s_waitcnt lgkmcnt(0)":::"memory"); \
      _Pragma("unroll") for(int d_=0;d_<2;++d_) _Pragma("unroll") for(int r=0;r<16;++r)o[d_][r]*=wsf[crow(r,hi)]; } }while(0)
  f32x16 pA0,pA1,pB0,pB1;
  #define BLD(X0,X1,tt) do{ const lds_cptr fp_=fl3+(tt)*256; _Pragma("unroll") for(int j_=0;j_<4;++j_){ const f32x4v a_=*(const __attribute__((address_space(3))) f32x4v*)(fp_+j_*32); const f32x4v b_=*(const __attribute__((address_space(3))) f32x4v*)(fp_+j_*32+128); \
      X0[4*j_]=a_[0];X0[4*j_+1]=a_[1];X0[4*j_+2]=a_[2];X0[4*j_+3]=a_[3]; X1[4*j_]=b_[0];X1[4*j_+1]=b_[1];X1[4*j_+2]=b_[2];X1[4*j_+3]=b_[3]; } }while(0)
  #define BSUB(X0,X1) do{ _Pragma("unroll") for(int r_=0;r_<16;++r_){X0[r_]=aq-X0[r_];X1[r_]=aq-X1[r_];} }while(0)
  int sl_prev=0,sl_cur=0,sl_next=SLOTB;
  #define ROT() do{sl_prev=sl_cur;sl_cur=sl_next;sl_next=(sl_next==(NSLOT-1)*SLOTB)?0:sl_next+SLOTB;}while(0)
  DMA_K(2,2*SLOTB);
  WAIT_BAR(3);
  fqv=*(const __attribute__((address_space(3))) float*)(shm3+LDS_F+(q0+wid*QBLK+r32)*4); aq=fqv;
  BLD(pA0,pA1,0); BSUB(pA0,pA1);
  qkt(pA0,pA1,Kbase,qr,r32,hi);asm volatile("s_nop 15\n\ts_nop 7":"+v"(pA0),"+v"(pA1));CMASK(pA0,pA1,0);
  START(pA0,pA1);
  _Pragma("unroll") for(int r=0;r<16;++r)pA1[r]=__builtin_amdgcn_exp2f(pA1[r]);
  BLD(pB0,pB1,1); BSUB(pB0,pB1);
  WAIT_BAR(0);
  DMA_K(3,0);DMA_V(1,SLOTB);
  ROT();
  kload8(kf,kp0+sl_cur);
  WAIT_BAR(2);
  s16x4 vlo[8],vhi[8]; u32x4 pw0,pw1,pw2,pw3;
  #define PKW(P,B) cvtpk_s(P[B],P[B+1])
  #define PAF(k) __builtin_bit_cast(bf16x8,pw##k)
  #define VFR(i) (bf16x8){vlo[i][0],vlo[i][1],vlo[i][2],vlo[i][3],vhi[i][0],vhi[i][1],vhi[i][2],vhi[i][3]}
  #define PIN(x) asm volatile("":"+v"(x))
  #define MX3(a,b,c) __builtin_fmaxf(__builtin_fmaxf((a),(b)),(c))
  #define GAPA(MF,A0,A1,A2,A3,W0,W1,PW) do{ MF; sacc+=A0; sacc+=A1; sacc+=A2; sacc+=A3; PIN(sacc); W0; W1; PIN(PW); SBAR(); }while(0)
  #define EX(v) __builtin_amdgcn_exp2f(v)
  #define GAPB(MF,X,B) do{ MF; X[B]=EX(X[B]); X[B+1]=EX(X[B+1]); X[B+2]=EX(X[B+2]); X[B+3]=EX(X[B+3]); PIN(X); SBAR(); }while(0)
  #define VRD(i) do{ vlo[i]=vtr(vp_+(((i)>>2)*4096+((i)&3)*1024)); vhi[i]=vtr(vp_+(((i)>>2)*4096+((i)&3)*1024+512)); }while(0)
  #define KRD(G,j) do{ if(G){ kload2(kf,kp0+sl_next,j); SBAR(); } }while(0)
  #define STEP(C0,C1,P0,P1,t,GK,GV,GL) do{ SBAR(); \
    const lds_cptr vp_=vp0+sl_prev; \
    VRD(0); SBAR(); float sacc=(P0[0]+P0[1]); \
    GAPA(C0=__builtin_amdgcn_mfma_f32_32x32x16_bf16(kf[0],qr[0],C0,0,0,0), P0[2],P0[3],P0[4],P0[5],     pw0[0]=PKW(P0,0), pw0[1]=PKW(P0,2), pw0); \
    VRD(4); SBAR(); GAPA(C1=__builtin_amdgcn_mfma_f32_32x32x16_bf16(kf[1],qr[0],C1,0,0,0), P0[6],P0[7],P0[8],P0[9],     pw0[2]=PKW(P0,4), pw0[3]=PKW(P0,6), pw0); \
    VRD(1); SBAR(); GAPA(C0=__builtin_amdgcn_mfma_f32_32x32x16_bf16(kf[2],qr[1],C0,0,0,0),   P0[10],P0[11],P0[12],P0[13], pw1[0]=PKW(P0,8), pw1[1]=PKW(P0,10), pw1); \
    VRD(5); SBAR(); GAPA(C1=__builtin_amdgcn_mfma_f32_32x32x16_bf16(kf[3],qr[1],C1,0,0,0),   P0[14],P0[15],P1[0],P1[1],   pw1[2]=PKW(P0,12),pw1[3]=PKW(P0,14), pw1); \
    VRD(2); SBAR(); GAPA(C0=__builtin_amdgcn_mfma_f32_32x32x16_bf16(kf[4],qr[2],C0,0,0,0),   P1[2],P1[3],P1[4],P1[5],     pw2[0]=PKW(P1,0), pw2[1]=PKW(P1,2), pw2); \
    VRD(6); SBAR(); GAPA(C1=__builtin_amdgcn_mfma_f32_32x32x16_bf16(kf[5],qr[2],C1,0,0,0),   P1[6],P1[7],P1[8],P1[9],     pw2[2]=PKW(P1,4), pw2[3]=PKW(P1,6), pw2); \
    VRD(3); SBAR(); GAPA(C0=__builtin_amdgcn_mfma_f32_32x32x16_bf16(kf[6],qr[3],C0,0,0,0),   P1[10],P1[11],P1[12],P1[13], pw3[0]=PKW(P1,8), pw3[1]=PKW(P1,10), pw3); \
    VRD(7); SBAR(); GAPA(C1=__builtin_amdgcn_mfma_f32_32x32x16_bf16(kf[7],qr[3],C1,0,0,0),   P1[14],P1[15],0.f,0.f,       pw3[2]=PKW(P1,12),pw3[3]=PKW(P1,14), pw3); \
    l_reg+=sacc; \
    if(GK){DMA_K((t)+3,sl_cur);} if(GV){DMA_V((t)+1,sl_next);} \
    CMASK(C0,C1,t); \
    { float a=MX3(C0[0],C0[1],C1[0]),b=MX3(C0[2],C0[3],C1[1]); a=MX3(a,C1[2],C1[3]); \
      _Pragma("unroll") for(int r=4;r<16;r+=4){a=MX3(a,C0[r],C0[r+1]);b=MX3(b,C0[r+2],C0[r+3]);a=MX3(a,C1[r],C1[r+1]);b=MX3(b,C1[r+2],C1[r+3]);} \
      float rm=__builtin_fmaxf(a,b); { auto rr=__builtin_amdgcn_permlane32_swap(__float_as_uint(rm),__float_as_uint(rm),false,false); rm=__builtin_fmaxf(__uint_as_float(rr[0]),__uint_as_float(rr[1])); } \
      resc=false; \
      if(__builtin_expect(__any(rm>(float)THRL),0)){ const float dl=__builtin_fmaxf(rm,0.f); mhat+=dl; \
        _Pragma("unroll") for(int r=0;r<16;++r){C0[r]-=dl;C1[r]-=dl;} \
        aq=fqv-mhat; \
        const float f=__builtin_amdgcn_exp2f(-dl); l_reg*=f; if(hi==0)wsf[r32]=f; resc=true; } } \
    SBAR(); \
    if(GL){ BLD(P0,P1,(t)+1); SBAR(); } \
    GAPB(o[0]=__builtin_amdgcn_mfma_f32_32x32x16_bf16(PAF(0),VFR(0),o[0],0,0,0), C0,0); \
    GAPB(o[1]=__builtin_amdgcn_mfma_f32_32x32x16_bf16(PAF(0),VFR(4),o[1],0,0,0), C0,4); \
    KRD(GL,0); GAPB(o[0]=__builtin_amdgcn_mfma_f32_32x32x16_bf16(PAF(1),VFR(1),o[0],0,0,0), C0,8); \
    KRD(GL,1); GAPB(o[1]=__builtin_amdgcn_mfma_f32_32x32x16_bf16(PAF(1),VFR(5),o[1],0,0,0), C0,12); \
    KRD(GL,2); GAPB(o[0]=__builtin_amdgcn_mfma_f32_32x32x16_bf16(PAF(2),VFR(2),o[0],0,0,0), C1,0); \
    KRD(GL,3); GAPB(o[1]=__builtin_amdgcn_mfma_f32_32x32x16_bf16(PAF(2),VFR(6),o[1],0,0,0), C1,4); \
    GAPB(o[0]=__builtin_amdgcn_mfma_f32_32x32x16_bf16(PAF(3),VFR(3),o[0],0,0,0), C1,8); \
    GAPB(o[1]=__builtin_amdgcn_mfma_f32_32x32x16_bf16(PAF(3),VFR(7),o[1],0,0,0), C1,12); \
    if(GL){ BSUB(P0,P1); SBAR(); } \
    }while(0)
  int t=1;
  #undef CMASK
  #define CMASK(P0,P1,t) do{}while(0)
  for(;t+5<NT;t+=2){
    STEP(pB0,pB1,pA0,pA1,t,true,true,true);     WAIT_BAR(2); RESC(); ROT();
    STEP(pA0,pA1,pB0,pB1,t+1,true,true,true);   WAIT_BAR(2); RESC(); ROT();
  }
  #undef CMASK
  #define CMASK(P0,P1,t) do{int jb_=(t)-(NT-4); if(jb_>=0)cmask(P0,P1,jb_,qrel,hi);}while(0)
  #define ENDW(tt) do{ if((tt)+3<NT){WAIT_BAR(2);} else if((tt)+2<NT){WAIT_BAR(1);} else {WAIT_BAR(0);} }while(0)
  for(;t+1<NT;t+=2){
    STEP(pB0,pB1,pA0,pA1,t,(t+3<NT),(t+1<NT),(t+1<NT));       ENDW(t);   RESC(); ROT();
    STEP(pA0,pA1,pB0,pB1,t+1,(t+4<NT),(t+2<NT),(t+2<NT));     ENDW(t+1); RESC(); ROT();
  }
  STEP(pB0,pB1,pA0,pA1,NT-1,false,false,false); RESC();
  { float sacc=pB0[0]+pB0[1]; _Pragma("unroll") for(int r=2;r<16;++r)sacc+=pB0[r]; _Pragma("unroll") for(int r=0;r<16;++r)sacc+=pB1[r]; l_reg+=sacc;
    pw0=(u32x4){PKW(pB0,0),PKW(pB0,2),PKW(pB0,4),PKW(pB0,6)};pw1=(u32x4){PKW(pB0,8),PKW(pB0,10),PKW(pB0,12),PKW(pB0,14)};pw2=(u32x4){PKW(pB1,0),PKW(pB1,2),PKW(pB1,4),PKW(pB1,6)};pw3=(u32x4){PKW(pB1,8),PKW(pB1,10),PKW(pB1,12),PKW(pB1,14)};
    SBAR(); pv(o,vb0+sl_cur,PAF(0),PAF(1),PAF(2),PAF(3)); }
  #undef PKW
  #undef PAF
  #undef VFR
  #undef PIN
  #undef MX3
  #undef GAPA
  #undef GAPB
  #undef EX
  #undef VRD
  #undef KRD
  #undef STEP
  #undef ENDW
  {auto rr=__builtin_amdgcn_permlane32_swap(__float_as_uint(l_reg),__float_as_uint(l_reg),false,false);l_reg=__uint_as_float(rr[0])+__uint_as_float(rr[1]);}
  if(hi==0)wsf[32+r32]=l_reg;asm volatile("s_waitcnt lgkmcnt(0)":::"memory");
  float rli[16];
  #pragma unroll
  for(int r=0;r<16;++r)rli[r]=__builtin_amdgcn_rcpf(wsf[32+crow(r,hi)]);
  bf16*Ow=O+(rowbase+q0+wid*QBLK)*DMO+h*D;
  { bf16*stg=(bf16*)(shm+LDS_OST)+wid*2048;
    #pragma unroll
    for(int r=0;r<16;++r){const int orow=crow(r,hi);
      #pragma unroll
      for(int d0=0;d0<2;++d0)stg[orow*64+d0*32+r32]=__float2bfloat16(o[d0][r]*rli[r]);}
    asm volatile("s_waitcnt lgkmcnt(0)":::"memory");
    #pragma unroll
    for(int i=0;i<4;++i){const int row=i*8+(lane>>3),ch=lane&7; const u32x4 v=*(const u32x4*)(stg+row*64+ch*8); ATTN_STORE16(Ow+(long)row*DMO+ch*8,v);} }
  asm volatile("s_waitcnt lgkmcnt(0)\n\ts_barrier":::"memory");
  #undef BLD
  #undef BSUB
  #undef DMA_K
  #undef DMA_V
  #undef CMASK
  #undef START
  #undef RESC
  #undef ROT
}
constexpr int ATTN_LDS_BYTES=LDS_BYTES;
struct AttnTensors { const bf16* Q; const bf16* K; const bf16* V; bf16* O; const float* F; const unsigned* AM; };
struct AttnUnit { int bh; int qb; };
struct StaticOrder {
  int vcu;
  __device__ __forceinline__ explicit StaticOrder(int grid,int block):vcu((block%8)*(grid/8)+block/8){}
  __device__ __forceinline__ bool next(int i,AttnUnit&u)const{ if(i>=2||vcu>=256)return false; const int s=vcu&7; u.bh=vcu>>3; u.qb=(i==0)?15-s:s; return true; }
  __device__ __forceinline__ void a_ready(const AttnUnit&)const{}
  __device__ __forceinline__ void done(const AttnUnit&)const{}
};
template<class Sched,int THRL=8> __device__ __forceinline__ void attn_phase(char*lds,const AttnTensors&T,const Sched&S){
  AttnUnit u;
  for(int i=0;S.next(i,u);++i){ S.a_ready(u); attn_unit<THRL>(u.bh/NHEAD,u.bh%NHEAD,u.qb,T.Q,T.K,T.V,T.O,T.F,T.AM,lds); S.done(u); }
}
#undef SBAR
#undef WAIT_BAR
}
constexpr int NWAVES = 8;
#ifndef PROBE_REP
#define PROBE_REP -1
#endif
#define REPN(k) for (int rep_ = 0; rep_ < ((PROBE_REP) == (k) ? 2 : 1); ++rep_)
#ifndef MK_N_LAUNCHES
#define MK_N_LAUNCHES 1
#endif
constexpr int N_PHASES = 11;
constexpr int N_LAUNCHES = MK_N_LAUNCHES;
static_assert(N_LAUNCHES == 1 || N_LAUNCHES == N_PHASES, "MK_N_LAUNCHES is 1 or 11");

constexpr int BATCH = 4, SEQ = 4096, D = 1024, M = BATCH * SEQ, NMEM = 256, MMEM = BATCH * NMEM, FF = 4096;
constexpr int INC = 3592, NIN = 3584;
constexpr int FOXH = 8, HGH = 4, CH = 64, NCH = SEQ / CH, NUNIT = BATCH * HGH * NCH;
constexpr float EPS = 1e-6f;
constexpr float LOG2E = 1.4426950408889634f;

constexpr size_t MiB = 1u << 20;
constexpr size_t WS_CTL = 0, CTL_ZERO_BYTES = 64 * 1024;
constexpr size_t WS_LOGF = 1 * MiB;
constexpr size_t WS_FCUM = WS_LOGF + MiB / 2;
constexpr size_t WS_DEC = 2 * MiB;
constexpr size_t WS_SS = 2 * MiB + MiB / 2;
constexpr size_t WS_MEMN = 4 * MiB, WS_KMEM = 6 * MiB, WS_VMEM = 8 * MiB, WS_WKT = 10 * MiB, WS_VWT = 18 * MiB;
constexpr size_t WS_WIN = 26 * MiB, WS_WXKV = 33 * MiB, WS_WOUT = 37 * MiB, WS_WQ = 39 * MiB, WS_WXO = 41 * MiB, WS_W1 = 43 * MiB, WS_W2 = 51 * MiB;
constexpr size_t WS_XN = 60 * MiB;
constexpr size_t WS_AO = 92 * MiB;
constexpr size_t WS_Q = 124 * MiB, WS_K = 140 * MiB, WS_V = 156 * MiB, WS_GQ = 172 * MiB, WS_GI = 188 * MiB, WS_GG = 204 * MiB, WS_G = 220 * MiB;
constexpr size_t WS_H = 124 * MiB;
constexpr size_t WS_END = 252 * MiB;

constexpr int CW_BAR = 4096, CW_AMAX = 8192;
constexpr int RING_OFF = 0, RING_BYTES = 131072;
constexpr int LDSCTL_OFF = RING_BYTES, MISC_OFF = LDSCTL_OFF + 320;
constexpr int LDS_BYTES = 147456;
static_assert(MISC_OFF + 128 <= LDS_BYTES, "LDS map");

#define GAS __attribute__((address_space(1)))
#define LAS __attribute__((address_space(3)))
typedef unsigned short bf16;
typedef unsigned v4u __attribute__((ext_vector_type(4)));
typedef unsigned v2u __attribute__((ext_vector_type(2)));
typedef float f32x4 __attribute__((ext_vector_type(4)));
typedef float f32x2 __attribute__((ext_vector_type(2)));
typedef short bf16x8 __attribute__((ext_vector_type(8)));
typedef GAS unsigned gu32;
#define RLX_AGENT __ATOMIC_RELAXED, __HIP_MEMORY_SCOPE_AGENT
#define LDS_WAIT() asm volatile("s_waitcnt lgkmcnt(0)" ::: "memory")
#define VM_WAIT() asm volatile("s_waitcnt vmcnt(0)" ::: "memory")
__device__ __forceinline__ unsigned f2bf(float f) { unsigned u = __builtin_bit_cast(unsigned, f); return (u + 0x7fffu + ((u >> 16) & 1u)) >> 16; }
__device__ __forceinline__ unsigned pk2(float lo, float hi) { unsigned r; asm("v_cvt_pk_bf16_f32 %0, %1, %2" : "=v"(r) : "v"(lo), "v"(hi)); return r; }
__device__ __forceinline__ float bf2f(unsigned short b) { return __builtin_bit_cast(float, (unsigned)b << 16); }
#define XB_TMO      128
#define XB_XCNT(j)  (256  + 64 * (j))
#define XB_XSUB(j)  (1280 + 64 * (j))
#define XB_XGEN(j)  (2304 + 64 * (j))
#define XB_TOP      3328
#define XB_TOPGEN   3392
#define XCD_BAR_WORDS 3456
#define XB_SPIN_CAP (1u << 18)

__device__ __forceinline__ unsigned xb_ld(unsigned* p)              { return __hip_atomic_load(p, __ATOMIC_RELAXED, __HIP_MEMORY_SCOPE_AGENT); }
__device__ __forceinline__ unsigned xb_add(unsigned* p, unsigned v) { return __hip_atomic_fetch_add(p, v, __ATOMIC_RELAXED, __HIP_MEMORY_SCOPE_AGENT); }
__device__ __forceinline__ unsigned xb_xcc_id() { return (unsigned)__builtin_amdgcn_s_getreg((3 << 11) | 20) & 0xFu; }
#define XB_SPIN(cond, bar) do { unsigned _sp = 0; while (cond) { __builtin_amdgcn_s_sleep(1); \
    if ((++_sp & 255u) == 0u) { if (xb_ld(&(bar)[XB_TMO])) break; if (_sp > XB_SPIN_CAP) { atomicAdd(&(bar)[XB_TMO], 1u); break; } } } } while (0)

struct XcdBarrier {
    unsigned* bar; unsigned x;
    volatile LAS unsigned* st;
};

__device__ __forceinline__ XcdBarrier xcd_barrier_post(unsigned* bar, volatile LAS unsigned* st) {
    XcdBarrier b; b.bar = bar; b.x = xb_xcc_id(); b.st = st;
    if (threadIdx.x == 0) (void)xb_add(&bar[XB_XCNT(b.x)], 1u);
    return b;
}
__device__ __forceinline__ void xcd_barrier_complete(unsigned* bar, unsigned x, unsigned& nloc, unsigned& nx) {
    const unsigned G = gridDim.x * gridDim.y * gridDim.z;
    unsigned sum, cnt, mine, sp = 0u;
    for (;;) {
        sum = 0u; cnt = 0u; mine = 0u;
#pragma unroll
        for (unsigned j = 0; j < 16; ++j) { const unsigned c = xb_ld(&bar[XB_XCNT(j)]); sum += c; cnt += (c > 0u) ? 1u : 0u; mine = (j == x) ? c : mine; }
        if (sum == G) break;
        __builtin_amdgcn_s_sleep(1);
        if ((++sp & 255u) == 0u) { if (xb_ld(&bar[XB_TMO])) break; if (sp > XB_SPIN_CAP) { atomicAdd(&bar[XB_TMO], 1u); break; } }
    }
    nloc = mine > 0u ? mine : 1u; nx = cnt > 0u ? cnt : 1u;
}

__device__ __forceinline__ void xcd_barrier(const XcdBarrier& b) {
    asm volatile("s_waitcnt vmcnt(0)" ::: "memory");
    __syncthreads();
    if (threadIdx.x == 0) {
        unsigned* bar = b.bar;
        __builtin_amdgcn_s_waitcnt(0);
        unsigned nloc = b.st[0], nx = b.st[1];
        if (nloc == 0u) { xcd_barrier_complete(bar, b.x, nloc, nx); b.st[0] = nloc; b.st[1] = nx; }
        const unsigned old = xb_add(&bar[XB_XSUB(b.x)], 1u);
        const unsigned gen = old / nloc;
        if (old + 1u == (gen + 1u) * nloc) {
            __builtin_amdgcn_fence(__ATOMIC_RELEASE, "agent");
            asm volatile("s_waitcnt vmcnt(0)" ::: "memory");
            const unsigned og = xb_add(&bar[XB_TOP], 1u);
            const unsigned tg = og / nx;
            if (og + 1u == (tg + 1u) * nx) xb_add(&bar[XB_TOPGEN], 1u);
            else XB_SPIN(xb_ld(&bar[XB_TOPGEN]) == tg, bar);
            __builtin_amdgcn_fence(__ATOMIC_ACQUIRE, "agent");
            xb_add(&bar[XB_XGEN(b.x)], 1u);
            asm volatile("s_waitcnt vmcnt(0)" ::: "memory");
        } else {
            XB_SPIN(xb_ld(&bar[XB_XGEN(b.x)]) == gen, bar);
            __builtin_amdgcn_fence(__ATOMIC_ACQUIRE, "agent");
            asm volatile("s_waitcnt vmcnt(0)" ::: "memory");
        }
    }
    __syncthreads();
}
struct Frame {
    LAS unsigned char* lds;
    volatile LAS unsigned* MISC;
    gu32* ctl;
    int tid, lane, wave;
    int vcu, G;
    const float* in[17]; float* out; unsigned char* ws;
};
template <int C> __device__ __forceinline__ float dpp_mov(float v) { return __builtin_bit_cast(float, __builtin_amdgcn_update_dpp(0, __builtin_bit_cast(int, v), C, 0xf, 0xf, true)); }
__device__ __forceinline__ float wave_sum(float v) {
    v += dpp_mov<0xB1>(v); v += dpp_mov<0x4E>(v); v += dpp_mov<0x141>(v); v += dpp_mov<0x140>(v);
    { auto rr = __builtin_amdgcn_permlane16_swap(__float_as_uint(v), __float_as_uint(v), false, false); v = __uint_as_float(rr[0]) + __uint_as_float(rr[1]); }
    { auto rr = __builtin_amdgcn_permlane32_swap(__float_as_uint(v), __float_as_uint(v), false, false); v = __uint_as_float(rr[0]) + __uint_as_float(rr[1]); }
    return v;
}
struct TItem { const float* W; int ldw, src_off, ncols, K; bf16* WT; int row_off; const float* gk; int item; };
constexpr int I_A = 16 * 48, I_B = 16 * 64, I_KV = 16 * 64, I_O = 16 * 32, I_XO = 16 * 32, I_1 = 16 * 128, I_2 = 64 * 32;
constexpr int NITEMS = I_A + I_B + I_KV + I_O + I_XO + I_1 + I_2;
__device__ __forceinline__ TItem t_decode(Frame& F, int it) {
    int r = it;
    if (r < I_A) return TItem{F.in[3], INC, 0, 1536, D, (bf16*)(F.ws + WS_WIN), 0, nullptr, r}; r -= I_A;
    if (r < I_B) return TItem{F.in[3], INC, 1544, 2048, D, (bf16*)(F.ws + WS_WIN), 1536, nullptr, r}; r -= I_B;
    if (r < I_KV) return TItem{F.in[11], 2 * D, 0, 2 * D, D, (bf16*)(F.ws + WS_WXKV), 0, nullptr, r}; r -= I_KV;
    if (r < I_O) return TItem{F.in[7], D, 0, D, D, (bf16*)(F.ws + WS_WOUT), 0, nullptr, r}; r -= I_O;
    if (r < I_XO) return TItem{F.in[12], D, 0, D, D, (bf16*)(F.ws + WS_WXO), 0, nullptr, r}; r -= I_XO;
    if (r < I_1) return TItem{F.in[14], FF, 0, FF, D, (bf16*)(F.ws + WS_W1), 0, F.in[13], r}; r -= I_1;
    return TItem{F.in[15], D, 0, D, FF, (bf16*)(F.ws + WS_W2), 0, nullptr, r};
}
__device__ __forceinline__ void t_load(const TItem& T, int lane, f32x4 (&w)[8], float (&gs)[8]) {
    const int nblk = T.ncols / 32, kb = T.item / nblk, nb = T.item % nblk, k0 = 64 * kb, n0 = 32 * nb, c4 = (lane & 7) * 4;
#pragma unroll
    for (int i = 0; i < 8; ++i) { const int kk = (lane >> 3) + 8 * i; w[i] = *(const GAS f32x4*)(T.W + (size_t)(k0 + kk) * T.ldw + T.src_off + n0 + c4); }
    if (T.gk) {
#pragma unroll
        for (int i = 0; i < 8; ++i) gs[i] = T.gk[k0 + (lane >> 3) + 8 * i]; }
    else {
#pragma unroll
        for (int i = 0; i < 8; ++i) gs[i] = 1.0f; }
}
__device__ __forceinline__ void t_finish(const TItem& T, int lane, const f32x4 (&w)[8], const float (&gs)[8], LAS float* scr) {
    const int nblk = T.ncols / 32, kb = T.item / nblk, nb = T.item % nblk, k0 = 64 * kb, n0 = 32 * nb, c4 = (lane & 7) * 4;
#pragma unroll
    for (int i = 0; i < 8; ++i) { const int kk = (lane >> 3) + 8 * i; const f32x4 t = w[i] * gs[i]; LAS float* p = scr + kk * 33 + c4; p[0] = t[0]; p[1] = t[1]; p[2] = t[2]; p[3] = t[3]; }
    LDS_WAIT(); asm volatile("" ::: "memory");
    const int c = lane & 7;
#pragma unroll
    for (int j = 0; j < 4; ++j) { const int n = (lane >> 3) + 8 * j; const LAS float* s = scr + (8 * c) * 33 + n;
        v4u o; o.x = pk2(s[0 * 33], s[1 * 33]); o.y = pk2(s[2 * 33], s[3 * 33]); o.z = pk2(s[4 * 33], s[5 * 33]); o.w = pk2(s[6 * 33], s[7 * 33]);
        *(GAS v4u*)(T.WT + (size_t)(T.row_off + n0 + n) * T.K + k0 + 8 * c) = o; }
    LDS_WAIT(); asm volatile("" ::: "memory");
}
__device__ __forceinline__ void p0_prologue(Frame& F) {
    constexpr int SCR_STRIDE = 8704;
    LAS float* scr = (LAS float*)(F.lds + RING_OFF + F.wave * SCR_STRIDE);
    LAS float* Wf = (LAS float*)(F.lds + RING_OFF + 8 * SCR_STRIDE);
    const float* x = F.in[0]; const float* mem = F.in[1]; const float* gmix = F.in[2]; const float* w_in = F.in[3]; const float* fbias = F.in[4];
    bf16* XN = (bf16*)(F.ws + WS_XN); bf16* MEMN = (bf16*)(F.ws + WS_MEMN); float* LOGF = (float*)(F.ws + WS_LOGF);
    for (int k = F.tid; k < 1024; k += NWAVES * 64) { const f32x4* p = (const f32x4*)(w_in + (size_t)k * INC + 1536); const int sl = ((k & 3) * 4 + (k >> 8)) * 64 + ((k >> 2) & 63); *(LAS f32x4*)(Wf + sl * 4) = p[0]; *(LAS f32x4*)(Wf + 4096 + sl * 4) = p[1]; }
    __syncthreads();
    const int gw = F.vcu * NWAVES + F.wave, NGW = F.G * NWAVES;
    {
        f32x4 g4[4];
#pragma unroll
        for (int j = 0; j < 4; ++j) g4[j] = ((const GAS f32x4*)gmix + F.lane)[64 * j];
        const float fbv = fbias[F.lane & 7];
        f32x4 v[4];
        if (gw < M) { const GAS f32x4* xr = (const GAS f32x4*)(x + (size_t)gw * D) + F.lane;
#pragma unroll
            for (int j = 0; j < 4; ++j) v[j] = xr[64 * j]; }
        for (int m = gw; m < M; m += NGW) {
            f32x4 nv[4]; const int mn = (m + NGW < M) ? m + NGW : m;
            { const GAS f32x4* xn = (const GAS f32x4*)(x + (size_t)mn * D) + F.lane;
#pragma unroll
              for (int j = 0; j < 4; ++j) nv[j] = xn[64 * j]; }
            float s = 0.f;
#pragma unroll
            for (int j = 0; j < 4; ++j) s += (v[j].x * v[j].x + v[j].y * v[j].y) + (v[j].z * v[j].z + v[j].w * v[j].w);
            const float rstd = 1.0f / sqrtf(wave_sum(s) * (1.f / D) + EPS);
            f32x4 fa = (f32x4){0.f, 0.f, 0.f, 0.f}, fb = fa;
            GAS v2u* o8 = (GAS v2u*)(XN + (size_t)m * D) + F.lane;
#pragma unroll
            for (int j = 0; j < 4; ++j) { const f32x4 hn = v[j] * rstd * g4[j];
                v2u w; w.x = pk2(hn.x, hn.y); w.y = pk2(hn.z, hn.w); o8[64 * j] = w;
#pragma unroll
                for (int e = 0; e < 4; ++e) { const LAS float* wf = Wf + ((e * 4 + j) * 64 + F.lane) * 4; const f32x4 w0 = *(const LAS f32x4*)wf, w1 = *(const LAS f32x4*)(wf + 4096);
                    fa += w0 * hn[e]; fb += w1 * hn[e]; } }
            const float ff[8] = {fa[0], fa[1], fa[2], fa[3], fb[0], fb[1], fb[2], fb[3]};
            float mine = 0.f;
#pragma unroll
            for (int h = 0; h < 8; ++h) { const float t = wave_sum(ff[h]); if (F.lane == h) mine = t; }
            if (F.lane < 8) { const float z = mine + fbv; LOGF[(size_t)m * 8 + F.lane] = fminf(z, 0.f) - log1pf(expf(-fabsf(z))); }
#pragma unroll
            for (int j = 0; j < 4; ++j) v[j] = nv[j];
        }
    }
    for (int m = gw; m < MMEM; m += NGW) {
        const GAS f32x4* xr = (const GAS f32x4*)(mem + (size_t)m * D) + F.lane; const GAS f32x4* gr = (const GAS f32x4*)F.in[9] + F.lane;
        f32x4 v[4], g4[4]; float s = 0.f;
#pragma unroll
        for (int j = 0; j < 4; ++j) { v[j] = xr[64 * j]; g4[j] = gr[64 * j]; }
#pragma unroll
        for (int j = 0; j < 4; ++j) s += (v[j].x * v[j].x + v[j].y * v[j].y) + (v[j].z * v[j].z + v[j].w * v[j].w);
        const float rstd = 1.0f / sqrtf(wave_sum(s) * (1.f / D) + EPS);
        GAS v2u* o8 = (GAS v2u*)(MEMN + (size_t)m * D) + F.lane;
#pragma unroll
        for (int j = 0; j < 4; ++j) { const f32x4 hn = v[j] * rstd * g4[j]; v2u w; w.x = pk2(hn.x, hn.y); w.y = pk2(hn.z, hn.w); o8[64 * j] = w; }
    }
    { const float* wq = F.in[10]; const float* gx = F.in[8]; bf16* WQ = (bf16*)(F.ws + WS_WQ);
      for (int k = gw; k < D; k += NGW) { const float g = gx[k]; const GAS f32x4* r = (const GAS f32x4*)(wq + (size_t)k * D) + F.lane; GAS v2u* o8 = (GAS v2u*)(WQ + (size_t)k * D) + F.lane;
#pragma unroll
          for (int j = 0; j < 4; ++j) { const f32x4 w = r[64 * j] * g; v2u p; p.x = pk2(w.x, w.y); p.y = pk2(w.z, w.w); o8[64 * j] = p; } } }
    if (gw < NITEMS) {
        TItem cur = t_decode(F, gw); f32x4 w[8]; float gs[8]; t_load(cur, F.lane, w, gs);
        for (int it = gw; it < NITEMS; it += NGW) {
            const bool more = it + NGW < NITEMS; TItem nxt = more ? t_decode(F, it + NGW) : cur; f32x4 wn[8]; float gn[8];
            if (more) t_load(nxt, F.lane, wn, gn);
            t_finish(cur, F.lane, w, gs, scr);
            if (more) {
#pragma unroll
                for (int i = 0; i < 8; ++i) { w[i] = wn[i]; gs[i] = gn[i]; } }
            cur = nxt;
        }
    }
    __syncthreads();
}
__device__ __forceinline__ void fcumsum(Frame& F, int bh) {
    const float* LOGF = (const float*)(F.ws + WS_LOGF); float* FC = (float*)(F.ws + WS_FCUM);
    LAS double* wt = (LAS double*)(F.lds + RING_OFF);
    const int b = bh >> 3, h = bh & 7, s0 = F.tid * 8;
    double v[8]; double run = 0.0;
#pragma unroll
    for (int i = 0; i < 8; ++i) { run += (double)LOGF[((size_t)b * SEQ + s0 + i) * 8 + h]; v[i] = run; }
    double inc = run;
#pragma unroll
    for (int o = 1; o < 64; o <<= 1) { const double t = __shfl_up(inc, o); if (F.lane >= o) inc += t; }
    if (F.lane == 63) wt[F.wave] = inc;
    __syncthreads();
    double base = inc - run;
    for (int w = 0; w < F.wave; ++w) base += wt[w];
#pragma unroll
    for (int i = 0; i < 8; ++i) FC[(size_t)bh * SEQ + s0 + i] = (float)((base + v[i]) * (double)LOG2E);
    __syncthreads();
}
constexpr int P72 = 72, P136 = 136;
#define HG_FRAG(base, row, pitch, kk) (*(const LAS bf16x8*)((base) + ((row) * (pitch) + (kk)) ))
__device__ __forceinline__ void hg_it_task(const bf16* GI, int row0, int hc, LAS bf16* IT, int task) {
    const int vp = task & 63, sb = task >> 6, v = 2 * vp, s0 = 8 * sb;
    unsigned w[8];
#pragma unroll
    for (int j = 0; j < 8; ++j) w[j] = *(const GAS unsigned*)(GI + (size_t)(row0 + s0 + j) * 512 + hc + v);
    v4u lo, hi;
    lo.x = (w[0] & 0xffffu) | (w[1] << 16); lo.y = (w[2] & 0xffffu) | (w[3] << 16); lo.z = (w[4] & 0xffffu) | (w[5] << 16); lo.w = (w[6] & 0xffffu) | (w[7] << 16);
    hi.x = (w[0] >> 16) | (w[1] & 0xffff0000u); hi.y = (w[2] >> 16) | (w[3] & 0xffff0000u); hi.z = (w[4] >> 16) | (w[5] & 0xffff0000u); hi.w = (w[6] >> 16) | (w[7] & 0xffff0000u);
    *(LAS v4u*)(IT + v * P72 + s0) = lo; *(LAS v4u*)(IT + (v + 1) * P72 + s0) = hi;
}
__device__ __forceinline__ void hg_local_states(Frame& F) {
    const float* G = (const float*)(F.ws + WS_G); const bf16* GI = (const bf16*)(F.ws + WS_GI); float* LT = F.out; float* DEC = (float*)(F.ws + WS_DEC);
    LAS bf16* KD = (LAS bf16*)(F.lds + RING_OFF);
    LAS bf16* IT = KD + 128 * P72;
    LAS float* BS = (LAS float*)(IT + 128 * P72);
    const int fr = F.lane & 15, fq = F.lane >> 4;
    for (int uid = F.vcu; uid < NUNIT; uid += F.G) {
        const int b = uid >> 8, h = (uid >> 6) & 3, c = uid & 63, row0 = b * SEQ + c * CH, hc = h * 128;
        {
            const int d = F.tid & 127, qd = F.tid >> 7;
            float gv[16];
#pragma unroll
            for (int j = 0; j < 16; ++j) gv[j] = G[(size_t)(row0 + qd * 16 + j) * 512 + hc + d];
            hg_it_task(GI, row0, hc, IT, F.tid);
            float tot = 0.f;
#pragma unroll
            for (int j = 0; j < 16; ++j) tot += gv[j];
            BS[qd * 128 + d] = tot;
            __syncthreads();
            float r = 0.f;
            for (int q2 = 3; q2 > qd; --q2) r += BS[q2 * 128 + d];
            float kd[16];
#pragma unroll
            for (int j = 15; j >= 0; --j) { kd[j] = (1.0f - __expf(gv[j])) * __expf(r); r += gv[j]; }
            v4u o; o.x = pk2(kd[0], kd[1]); o.y = pk2(kd[2], kd[3]); o.z = pk2(kd[4], kd[5]); o.w = pk2(kd[6], kd[7]);
            *(LAS v4u*)(KD + d * P72 + qd * 16) = o;
            o.x = pk2(kd[8], kd[9]); o.y = pk2(kd[10], kd[11]); o.z = pk2(kd[12], kd[13]); o.w = pk2(kd[14], kd[15]);
            *(LAS v4u*)(KD + d * P72 + qd * 16 + 8) = o;
            if (qd == 0) DEC[(size_t)uid * 128 + d] = __expf(r);
        }
        __syncthreads();
        f32x4 acc[8];
#pragma unroll
        for (int n = 0; n < 8; ++n) acc[n] = (f32x4){0.f, 0.f, 0.f, 0.f};
#pragma unroll
        for (int kk = 0; kk < 2; ++kk) { const bf16x8 a = HG_FRAG(IT, 16 * F.wave + fr, P72, 32 * kk + 8 * fq);
#pragma unroll
            for (int n = 0; n < 8; ++n) { const bf16x8 bq = HG_FRAG(KD, 16 * n + fr, P72, 32 * kk + 8 * fq); acc[n] = __builtin_amdgcn_mfma_f32_16x16x32_bf16(bq, a, acc[n], 0, 0, 0); } }
        float* lt = LT + (size_t)uid * 16384 + (size_t)(16 * F.wave + fr) * 128 + 4 * fq;
#pragma unroll
        for (int n = 0; n < 8; ++n) *(GAS f32x4*)(lt + 16 * n) = acc[n];
        __syncthreads();
    }
}
__device__ __forceinline__ void hg_scan(Frame& F) {
    const float* LT = F.out; const float* DEC = (const float*)(F.ws + WS_DEC); bf16* SP = (bf16*)(F.ws + WS_XN);
    for (int idx = F.vcu * (NWAVES * 64) + F.tid; idx < 16 * 128 * 64; idx += F.G * NWAVES * 64) {
        const int bh = idx >> 13, rem = idx & 8191, v = rem >> 6, d2 = (rem & 63) * 2;
        float s0 = 0.f, s1 = 0.f;
        for (int c0 = 0; c0 < NCH; c0 += 8) {
            f32x2 l[8], dc[8];
#pragma unroll
            for (int j = 0; j < 8; ++j) { const size_t uid = (size_t)bh * 64 + c0 + j; l[j] = *(const GAS f32x2*)(LT + uid * 16384 + v * 128 + d2); dc[j] = *(const GAS f32x2*)(DEC + uid * 128 + d2); }
#pragma unroll
            for (int j = 0; j < 8; ++j) { const size_t uid = (size_t)bh * 64 + c0 + j;
                *(GAS unsigned*)(SP + uid * 16384 + v * 128 + d2) = pk2(s0, s1);
                s0 = dc[j].x * s0 + l[j].x; s1 = dc[j].y * s1 + l[j].y; }
        }
    }
}
__device__ __forceinline__ void hg_outputs(Frame& F) {
    const float* G = (const float*)(F.ws + WS_G); const bf16* GQ = (const bf16*)(F.ws + WS_GQ); const bf16* GI = (const bf16*)(F.ws + WS_GI); const bf16* GG = (const bf16*)(F.ws + WS_GG);
    const bf16* SPg = (const bf16*)(F.ws + WS_XN); bf16* AO = (bf16*)(F.ws + WS_AO); const float* gn = F.in[6];
    LAS bf16* QT = (LAS bf16*)(F.lds + RING_OFF);
    LAS bf16* KT = QT + 64 * P136;
    LAS bf16* IT = KT + 64 * P136;
    LAS bf16* SP = IT + 128 * P72;
    LAS bf16* AT = SP + 128 * P136;
    LAS float* RS = (LAS float*)(AT + 64 * P72);
    LAS float* BS = RS + 128;
    const int fr = F.lane & 15, fq = F.lane >> 4, mt = F.wave & 3, nh = F.wave >> 2;
    for (int uid = F.vcu; uid < NUNIT; uid += F.G) {
        const int b = uid >> 8, h = (uid >> 6) & 3, c = uid & 63, row0 = b * SEQ + c * CH, hc = h * 128;
        {
            const int d = F.tid & 127, qd = F.tid >> 7;
            float gv[16]; unsigned short qv[16];
#pragma unroll
            for (int j = 0; j < 16; ++j) { gv[j] = G[(size_t)(row0 + qd * 16 + j) * 512 + hc + d]; qv[j] = GQ[(size_t)(row0 + qd * 16 + j) * 512 + hc + d]; }
            v4u sp[4];
#pragma unroll
            for (int i = 0; i < 4; ++i) { const int ch = F.tid + 512 * i; sp[i] = *(const GAS v4u*)(SPg + (size_t)uid * 16384 + (ch >> 4) * 128 + (ch & 15) * 8); }
            hg_it_task(GI, row0, hc, IT, F.tid);
#pragma unroll
            for (int i = 0; i < 4; ++i) { const int ch = F.tid + 512 * i; *(LAS v4u*)(SP + (ch >> 4) * P136 + (ch & 15) * 8) = sp[i]; }
            float tot = 0.f;
#pragma unroll
            for (int j = 0; j < 16; ++j) tot += gv[j];
            BS[qd * 128 + d] = tot;
            __syncthreads();
            float bc = 0.f;
            for (int q2 = 0; q2 < qd; ++q2) bc += BS[q2 * 128 + d];
#pragma unroll
            for (int j = 0; j < 16; ++j) { bc += gv[j]; const int s_ = qd * 16 + j;
                QT[s_ * P136 + d] = (bf16)f2bf(bf2f(qv[j]) * __expf(bc)); KT[s_ * P136 + d] = (bf16)f2bf((1.0f - __expf(gv[j])) * __expf(-bc)); }
        }
        __syncthreads();
        {
            f32x4 a2[2] = {(f32x4){0.f, 0.f, 0.f, 0.f}, (f32x4){0.f, 0.f, 0.f, 0.f}};
#pragma unroll
            for (int kk = 0; kk < 4; ++kk) { const bf16x8 a = HG_FRAG(QT, 16 * mt + fr, P136, 32 * kk + 8 * fq);
#pragma unroll
                for (int n = 0; n < 2; ++n) { const bf16x8 bq = HG_FRAG(KT, 16 * (2 * nh + n) + fr, P136, 32 * kk + 8 * fq); a2[n] = __builtin_amdgcn_mfma_f32_16x16x32_bf16(bq, a, a2[n], 0, 0, 0); } }
            const int t = 16 * mt + fr;
#pragma unroll
            for (int n = 0; n < 2; ++n) { const int s = 16 * (2 * nh + n) + 4 * fq; v2u w;
                w.x = pk2(s <= t ? a2[n][0] : 0.f, s + 1 <= t ? a2[n][1] : 0.f); w.y = pk2(s + 2 <= t ? a2[n][2] : 0.f, s + 3 <= t ? a2[n][3] : 0.f);
                *(LAS v2u*)(AT + t * P72 + s) = w; }
        }
        __syncthreads();
        f32x4 acc[4];
#pragma unroll
        for (int n = 0; n < 4; ++n) acc[n] = (f32x4){0.f, 0.f, 0.f, 0.f};
#pragma unroll
        for (int kk = 0; kk < 2; ++kk) { const bf16x8 a = HG_FRAG(AT, 16 * mt + fr, P72, 32 * kk + 8 * fq);
#pragma unroll
            for (int n = 0; n < 4; ++n) { const bf16x8 bq = HG_FRAG(IT, 16 * (4 * nh + n) + fr, P72, 32 * kk + 8 * fq); acc[n] = __builtin_amdgcn_mfma_f32_16x16x32_bf16(bq, a, acc[n], 0, 0, 0); } }
#pragma unroll
        for (int kk = 0; kk < 4; ++kk) { const bf16x8 a = HG_FRAG(QT, 16 * mt + fr, P136, 32 * kk + 8 * fq);
#pragma unroll
            for (int n = 0; n < 4; ++n) { const bf16x8 bq = HG_FRAG(SP, 16 * (4 * nh + n) + fr, P136, 32 * kk + 8 * fq); acc[n] = __builtin_amdgcn_mfma_f32_16x16x32_bf16(bq, a, acc[n], 0, 0, 0); } }
        float q = 0.f;
#pragma unroll
        for (int n = 0; n < 4; ++n) q += (acc[n][0] * acc[n][0] + acc[n][1] * acc[n][1]) + (acc[n][2] * acc[n][2] + acc[n][3] * acc[n][3]);
        q += __shfl_xor(q, 16); q += __shfl_xor(q, 32);
        const int t = 16 * mt + fr;
        if (fq == 0) RS[t * 2 + nh] = q;
        __syncthreads();
        const float rstd = 1.0f / sqrtf((RS[t * 2] + RS[t * 2 + 1]) * (1.0f / 128.0f) + EPS);
#pragma unroll
        for (int n = 0; n < 4; ++n) { const int v = 16 * (4 * nh + n) + 4 * fq; const f32x4 g4 = *(const GAS f32x4*)(gn + v);
            const v2u gg = *(const GAS v2u*)(GG + (size_t)(row0 + t) * 512 + hc + v);
            const float o0 = acc[n][0] * rstd * g4[0] * bf2f((unsigned short)(gg.x & 0xffffu)), o1 = acc[n][1] * rstd * g4[1] * bf2f((unsigned short)(gg.x >> 16));
            const float o2 = acc[n][2] * rstd * g4[2] * bf2f((unsigned short)(gg.y & 0xffffu)), o3 = acc[n][3] * rstd * g4[3] * bf2f((unsigned short)(gg.y >> 16));
            v2u w; w.x = pk2(o0, o1); w.y = pk2(o2, o3); *(GAS v2u*)(AO + (size_t)(row0 + t) * 1024 + 512 + hc + v) = w; }
        __syncthreads();
    }
}
struct Args { const float* in[17]; float* out; unsigned char* ws; int ph_lo, ph_hi, li, pad; };
__global__ void __launch_bounds__(NWAVES * 64, 2) fwd_mega(Args args) {
    extern __shared__ __attribute__((aligned(16))) unsigned char lds[];
    Frame F;
    F.lds = (LAS unsigned char*)lds;
    F.MISC = (volatile LAS unsigned*)(F.lds + MISC_OFF);
    F.tid = threadIdx.x; F.lane = F.tid & 63; F.wave = __builtin_amdgcn_readfirstlane(F.tid >> 6);
    F.G = gridDim.x; { const int bx = blockIdx.x; F.vcu = (F.G % 8 == 0) ? (bx % 8) * (F.G / 8) + bx / 8 : bx; }
    F.ws = args.ws; F.out = args.out; F.ctl = (gu32*)(args.ws + WS_CTL);
#pragma unroll
    for (int i = 0; i < 17; ++i) F.in[i] = args.in[i];
    unsigned char* ws = args.ws;
    for (int u = F.tid; u < (LDS_BYTES - LDSCTL_OFF) / 4; u += NWAVES * 64) ((LAS unsigned*)(F.lds + LDSCTL_OFF))[u] = 0u;
    __syncthreads();
    XcdBarrier bar; bar.bar = (unsigned*)(F.ctl + CW_BAR); bar.x = 0; bar.st = nullptr;
    if (N_LAUNCHES == 1) bar = xcd_barrier_post((unsigned*)(F.ctl + CW_BAR), F.MISC + 8);
#define GRID_BAR() do { if (N_LAUNCHES == 1) xcd_barrier(bar); } while (0)
    const int lo = args.ph_lo, hi = args.ph_hi;
#define IN(k) (lo <= (k) && (k) < hi)
#define BOTH(k) (IN(k) && IN((k) + 1))
    const int cb = (int)blockIdx.x;
    float* SS = (float*)(ws + WS_SS);
    bf16* XB = (bf16*)(ws + WS_XN); bf16* AO = (bf16*)(ws + WS_AO);

    if (IN(0)) { REPN(0) p0_prologue(F); if (BOTH(0)) GRID_BAR(); }

    if (IN(1)) {
        if (cb >= 160 && cb < 192) fcumsum(F, cb - 160);
        REPN(1) { pg8::Gemm g{(const pg8::bf16_t*)(ws + WS_XN), (const pg8::bf16_t*)(ws + WS_WIN), D, D}; pg8::StaticOrder S; S.init(M, NIN, F.G, cb);
          pg8::EpiIn E; E.Ob = (pg8::bf16_t*)(ws + WS_Q); E.ostride = (size_t)(WS_K - WS_Q) / 2;
          static_assert(WS_V - WS_K == WS_K - WS_Q && WS_GQ - WS_V == WS_K - WS_Q && WS_GI - WS_GQ == WS_K - WS_Q && WS_GG - WS_GI == WS_K - WS_Q, "group outputs equally spaced");
          E.amax = (unsigned*)(F.ctl + CW_AMAX); E.G = (float*)(ws + WS_G); E.lbl = F.in[5]; E.qscale = attn_body::C2;
          pg8::gemm_phase<pg8::EpiIn, pg8::StaticOrder, PG8_ALIGN, PG8_SP2>(F.lds + RING_OFF, g, S, E); }
        { pg8::Gemm g{(const pg8::bf16_t*)(ws + WS_MEMN), (const pg8::bf16_t*)(ws + WS_WXKV), D, D}; pg8::StaticOrder S; S.init(MMEM, 2 * D, F.G, (cb >= 128 && cb < 160) ? cb - 128 : -1);
          pg8::EpiBf16 E{(pg8::bf16_t*)(ws + WS_KMEM), D, D, (size_t)(WS_VMEM - WS_KMEM) / 2, 1.0f};
          pg8::gemm_phase<pg8::EpiBf16, pg8::StaticOrder, PG8_ALIGN, PG8_SP2>(F.lds + RING_OFF, g, S, E); }
        if (BOTH(1)) GRID_BAR();
    }

    if (IN(2)) {
        REPN(2) { const attn_body::AttnTensors AT{(const attn_body::bf16*)(ws + WS_Q), (const attn_body::bf16*)(ws + WS_K), (const attn_body::bf16*)(ws + WS_V), (attn_body::bf16*)(ws + WS_AO), (const float*)(ws + WS_FCUM), (const unsigned*)(F.ctl + CW_AMAX)};
          const attn_body::StaticOrder S((int)F.G, (int)blockIdx.x);
          attn_body::attn_phase<attn_body::StaticOrder>((char*)lds + RING_OFF, AT, S); }
        __syncthreads();
        REPN(3) hg_local_states(F);
        REPN(4) { const bool wk = cb < 64; pg8::Gemm g{(const pg8::bf16_t*)(ws + (wk ? WS_KMEM : WS_WXO)), (const pg8::bf16_t*)(ws + (wk ? WS_WQ : WS_VMEM)), 256, D};
          pg8::SmallOrder S{wk ? 0 : 1, cb < 128 ? (cb & 63) : -1};
          pg8::EpiBf16 E{(pg8::bf16_t*)(ws + (wk ? WS_WKT : WS_VWT)), D, 0, 0, wk ? 0.0625f * LOG2E : 1.0f};
          pg8::gemm_phase<pg8::EpiBf16, pg8::SmallOrder, PG8_ALIGN, PG8_SP2>(F.lds + RING_OFF, g, S, E); }
        if (BOTH(2)) GRID_BAR();
    }
    if (IN(3)) { REPN(5) hg_scan(F); if (BOTH(3)) GRID_BAR(); }
    if (IN(4)) { REPN(6) hg_outputs(F); if (BOTH(4)) GRID_BAR(); }
    if (IN(5)) {
        pg8::Gemm g{(const pg8::bf16_t*)AO, (const pg8::bf16_t*)(ws + WS_WOUT), D, D}; pg8::StaticOrder S; S.init(M, D, F.G, cb);
        pg8::EpiRes E{F.in[0], F.out, (pg8::bf16_t*)XB, SS};
        REPN(7) pg8::gemm_phase<pg8::EpiRes, pg8::StaticOrder, PG8_ALIGN, PG8_SP2>(F.lds + RING_OFF, g, S, E);
        if (BOTH(5)) GRID_BAR();
    }
    if (IN(6)) {
        pg8::Gemm g{(const pg8::bf16_t*)XB, (const pg8::bf16_t*)(ws + WS_WKT), D, D}; pg8::StaticOrder S; S.init(M, D, F.G, cb, SEQ / 256, (size_t)D * D * 2);
        pg8::EpiSoftmax E{(pg8::bf16_t*)AO, SS};
        REPN(8) if (F.G == 256) pg8::gemm_phase<pg8::EpiSoftmax, pg8::StaticOrder, false, PG8_SP2>(F.lds + RING_OFF, g, S, E);
        if (BOTH(6)) GRID_BAR();
    }
    if (IN(7)) {
        pg8::Gemm g{(const pg8::bf16_t*)AO, (const pg8::bf16_t*)(ws + WS_VWT), D, D}; pg8::StaticOrder S; S.init(M, D, F.G, cb, SEQ / 256, (size_t)D * D * 2);
        pg8::EpiRes E{F.out, F.out, (pg8::bf16_t*)XB, SS};
        pg8::gemm_phase<pg8::EpiRes, pg8::StaticOrder, PG8_ALIGN, PG8_SP2>(F.lds + RING_OFF, g, S, E);
        if (BOTH(7)) GRID_BAR();
    }
    if (IN(8)) {
        pg8::Gemm g{(const pg8::bf16_t*)XB, (const pg8::bf16_t*)(ws + WS_W1), D, D}; pg8::StaticOrder S; S.init(M, FF, F.G, cb);
        pg8::EpiRelu2 E{(pg8::bf16_t*)(ws + WS_H), SS};
        REPN(9) pg8::gemm_phase<pg8::EpiRelu2, pg8::StaticOrder, PG8_ALIGN, PG8_SP2>(F.lds + RING_OFF, g, S, E);
        if (BOTH(8)) GRID_BAR();
    }
    if (IN(9)) {
        pg8::Gemm g{(const pg8::bf16_t*)(ws + WS_H), (const pg8::bf16_t*)(ws + WS_W2), FF, FF}; pg8::StaticOrder S; S.init(M, D, F.G, cb);
        pg8::EpiRes E{F.out, F.out, nullptr, SS};
        pg8::gemm_phase<pg8::EpiRes, pg8::StaticOrder, PG8_ALIGN, PG8_SP2>(F.lds + RING_OFF, g, S, E);
        if (BOTH(9)) GRID_BAR();
    }
    if (IN(10)) {
        const int gw = F.vcu * NWAVES + F.wave, NGW = F.G * NWAVES; const GAS f32x4* gr = (const GAS f32x4*)F.in[16] + F.lane;
        for (int m = gw; m < M; m += NGW) {
            GAS f32x4* xr = (GAS f32x4*)(F.out + (size_t)m * D) + F.lane; f32x4 v[4]; float s = 0.f;
#pragma unroll
            for (int j = 0; j < 4; ++j) { v[j] = xr[64 * j]; s += (v[j].x * v[j].x + v[j].y * v[j].y) + (v[j].z * v[j].z + v[j].w * v[j].w); }
            const float rstd = 1.0f / sqrtf(wave_sum(s) * (1.f / D) + EPS);
#pragma unroll
            for (int j = 0; j < 4; ++j) xr[64 * j] = v[j] * rstd * gr[64 * j];
        }
    }
#undef IN
#undef BOTH
}

extern "C" void kernel_launch(void* const* d_in, const int* in_sizes, int n_in, void* d_out, int out_size, void* d_ws, size_t ws_size, hipStream_t stream) {
    static int grid = 0;
    if (grid == 0) {
        if (n_in != 17 || in_sizes[0] != M * D || out_size != M * D || ws_size < WS_END) { fprintf(stderr, "kernel_launch: unexpected problem (n_in %d, in0 %d, out %d, ws %zu); nothing launched\n", n_in, n_in > 0 ? in_sizes[0] : -1, out_size, ws_size); grid = -1; return; }
        int dev = 0, cus = 0, per_cu = 0;
        if (hipGetDevice(&dev) != hipSuccess || hipDeviceGetAttribute(&cus, hipDeviceAttributeMultiprocessorCount, dev) != hipSuccess) { fprintf(stderr, "kernel_launch: device query failed\n"); grid = -1; return; }
        if (hipFuncSetAttribute((const void*)fwd_mega, hipFuncAttributeMaxDynamicSharedMemorySize, LDS_BYTES) != hipSuccess) { fprintf(stderr, "kernel_launch: hipFuncSetAttribute failed\n"); grid = -1; return; }
        if (hipOccupancyMaxActiveBlocksPerMultiprocessor(&per_cu, (const void*)fwd_mega, NWAVES * 64, LDS_BYTES) != hipSuccess || per_cu < 1)
            fprintf(stderr, "kernel_launch: note: occupancy query reports %d workgroups per CU\n", per_cu);
        (void)hipGetLastError();
        grid = cus;
        if (grid != 256) fprintf(stderr, "kernel_launch: %d CUs; this kernel is built for 256\n", grid);
    }
    if (grid < 0) return;
    if (hipMemsetAsync((char*)d_ws + WS_CTL, 0, CTL_ZERO_BYTES, stream) != hipSuccess) { fprintf(stderr, "kernel_launch: memset failed\n"); return; }
    Args a{};
    for (int i = 0; i < 17; ++i) a.in[i] = (const float*)d_in[i];
    a.out = (float*)d_out; a.ws = (unsigned char*)d_ws;
    for (int li = 0; li < N_LAUNCHES; ++li) {
        a.ph_lo = (N_LAUNCHES == 1) ? 0 : li; a.ph_hi = (N_LAUNCHES == 1) ? N_PHASES : li + 1; a.li = li;
        hipLaunchKernelGGL(fwd_mega, dim3(grid), dim3(NWAVES * 64), LDS_BYTES, stream, a);
        const hipError_t le = hipPeekAtLastError();
        if (le != hipSuccess) { fprintf(stderr, "kernel_launch: launch %d failed: %s\n", li, hipGetErrorName(le)); break; }
    }
}
```
